# Optimizing an MI355X kernel written in HIP

```python
import jax
import jax.numpy as jnp
from jax import lax
import numpy as np

D_MODEL = 1024
BATCH = 4
SEQ = 8192
DEPTH = 1

MIX_WIDTH = D_MODEL
HGRN_WIDTH = MIX_WIDTH // 2
HGRN_HEAD_DIM = 128
HGRN_HEADS = HGRN_WIDTH // HGRN_HEAD_DIM
HGRN_CHUNK = 64
GMLP_WIDTH = MIX_WIDTH - HGRN_WIDTH
GMLP_GROUP_DIM = 128
GMLP_GROUPS = GMLP_WIDTH // GMLP_GROUP_DIM
GMLP_CHUNK = 128
IN_COLS = 4 * HGRN_WIDTH + 2 * GMLP_WIDTH
PEER_HEADS = 8
PEER_N_KEYS = 128
PEER_N_EXPERTS = PEER_N_KEYS * PEER_N_KEYS
PEER_TOPK = 16
PEER_QUERY_DIM = 256
PEER_HALF = PEER_QUERY_DIM // 2
PEER_TOKEN_BLOCK = 128
NORM_EPS = 1e-6

kernel_name = 'hymba_hgrn2_gmlp_peer_adaln_layer'


def rmsnorm(x, g):
    xf = x.astype(jnp.float32)
    y = xf * lax.rsqrt(jnp.mean(xf * xf, axis=-1, keepdims=True) + NORM_EPS)
    return (y * g.astype(jnp.float32)).astype(x.dtype)


def layernorm(x, g, b):
    xf = x.astype(jnp.float32)
    mu = jnp.mean(xf, axis=-1, keepdims=True)
    var = jnp.mean(jnp.square(xf - mu), axis=-1, keepdims=True)
    y = (xf - mu) * lax.rsqrt(var + NORM_EPS)
    return (y * g.astype(jnp.float32) + b.astype(jnp.float32)).astype(x.dtype)


def hgrn2_chunkwise(q, k, v, logf):
    b_, s_, h_, dk = q.shape
    dv = v.shape[-1]
    nc = s_ // HGRN_CHUNK

    def to_chunks(t):
        return t.reshape(b_, nc, HGRN_CHUNK, h_, t.shape[-1]).transpose(1, 0, 3, 2, 4)

    qc, kc, vc = to_chunks(q), to_chunks(k), to_chunks(v)
    bc = jnp.cumsum(to_chunks(logf), axis=-2)
    causal = jnp.tril(jnp.ones((HGRN_CHUNK, HGRN_CHUNK), dtype=bool))[:, :, None]

    def step(state, inp):
        q_c, k_c, v_c, b_c = inp
        diff = b_c[..., :, None, :] - b_c[..., None, :, :]
        decay = jnp.exp(jnp.where(causal, diff, -jnp.inf))
        scores = jnp.einsum('bhtk,bhtsk,bhsk->bhts', q_c, decay, k_c)
        intra = jnp.einsum('bhts,bhsv->bhtv', scores, v_c)
        inter = jnp.einsum('bhtk,bhkv->bhtv', q_c * jnp.exp(b_c), state)
        b_last = b_c[..., -1:, :]
        new_state = (jnp.exp(b_last[..., 0, :])[..., None] * state
                     + jnp.einsum('bhsk,bhsv->bhkv', k_c * jnp.exp(b_last - b_c), v_c))
        return new_state, intra + inter

    state0 = jnp.zeros((b_, h_, dk, dv), jnp.float32)
    _, oc = lax.scan(step, state0, (qc, kc, vc, bc))
    return oc.transpose(1, 0, 3, 2, 4).reshape(b_, s_, h_, dv)


def hybrid_mixer(h, w_in, lb, hgrn_norm_g, gmlp_ln_g, gmlp_ln_b, spatial_w, spatial_b, gmlp_norm_g, w_out):
    b_, s_, _ = h.shape
    f32 = jnp.float32
    proj = h @ w_in
    cuts = [HGRN_WIDTH, 2 * HGRN_WIDTH, 3 * HGRN_WIDTH, 4 * HGRN_WIDTH, 4 * HGRN_WIDTH + GMLP_WIDTH]
    q, fz, inp, og, u, v = jnp.split(proj, cuts, axis=-1)

    heads = lambda t: t.reshape(b_, s_, HGRN_HEADS, HGRN_HEAD_DIM)
    fz32 = fz.astype(f32)
    logf = jnp.log(lb + (1.0 - lb) * jax.nn.sigmoid(fz32))
    key_gate = (1.0 - lb) * jax.nn.sigmoid(-fz32)
    q_feat = jax.nn.silu(q.astype(f32))
    o = hgrn2_chunkwise(heads(q_feat), heads(key_gate), heads(inp.astype(f32)), heads(logf))
    o = rmsnorm(o, hgrn_norm_g.reshape(HGRN_HEADS, HGRN_HEAD_DIM))
    o = o * heads(jax.nn.silu(og.astype(f32)))
    o = o.reshape(b_, s_, HGRN_WIDTH).astype(h.dtype)

    u = jax.nn.gelu(u)
    v = layernorm(jax.nn.gelu(v), gmlp_ln_g, gmlp_ln_b)
    nch = s_ // GMLP_CHUNK
    vc = v.reshape(b_, nch, GMLP_CHUNK, GMLP_GROUPS, GMLP_GROUP_DIM)
    tri = jnp.tril(jnp.ones((GMLP_CHUNK, GMLP_CHUNK), dtype=bool))[None]
    w_mask = jnp.where(tri, spatial_w, 0)
    mixed = jnp.einsum('gts,bnsgc->bntgc', w_mask, vc) + spatial_b.T[None, None, :, :, None]
    gm = u.reshape(b_, nch, GMLP_CHUNK, GMLP_GROUPS, GMLP_GROUP_DIM) * mixed
    gm = rmsnorm(gm.reshape(b_, s_, GMLP_GROUPS, GMLP_GROUP_DIM), gmlp_norm_g.reshape(GMLP_GROUPS, GMLP_GROUP_DIM))
    gm = gm.reshape(b_, s_, GMLP_WIDTH).astype(h.dtype)

    return jnp.concatenate([o, gm], axis=-1) @ w_out


def peer_ffn(h, wq, keys, u_tab, v_tab):
    b_, s_, d_ = h.shape
    t_ = b_ * s_
    hf = h.reshape(t_, d_)
    q = (hf @ wq).reshape(t_, PEER_HEADS, 2, PEER_HALF)
    sim = jnp.einsum('thpd,hpnd->thpn', q, keys)
    s1, i1 = lax.top_k(sim[:, :, 0, :], PEER_TOPK)
    s2, i2 = lax.top_k(sim[:, :, 1, :], PEER_TOPK)
    cand_s = (s1[..., :, None] + s2[..., None, :]).reshape(t_, PEER_HEADS, PEER_TOPK * PEER_TOPK)
    cand_i = (i1[..., :, None] * PEER_N_KEYS + i2[..., None, :]).reshape(t_, PEER_HEADS, PEER_TOPK * PEER_TOPK)
    top_s, pos = lax.top_k(cand_s, PEER_TOPK)
    idx = jnp.take_along_axis(cand_i, pos, axis=-1)
    gate = jax.nn.softmax(top_s.astype(jnp.float32), axis=-1).astype(h.dtype)
    nb = t_ // PEER_TOKEN_BLOCK
    idx_b = idx.reshape(nb, PEER_TOKEN_BLOCK, PEER_HEADS * PEER_TOPK)
    gate_b = gate.reshape(nb, PEER_TOKEN_BLOCK, PEER_HEADS * PEER_TOPK)
    h_b = hf.reshape(nb, PEER_TOKEN_BLOCK, d_)

    def block(args):
        hb, ib, gb = args
        u_sel = jnp.take(u_tab, ib, axis=0)
        act = jax.nn.gelu(jnp.einsum('tkd,td->tk', u_sel, hb)) * gb
        return jnp.einsum('tk,tkd->td', act, jnp.take(v_tab, ib, axis=0))

    y = lax.map(block, (h_b, idx_b, gate_b))
    return y.reshape(b_, s_, d_)


def setup_inputs(seed: int = 0) -> dict:
    key = jax.random.key(seed)
    ks = jax.random.split(key, 20)
    f32 = jnp.float32

    def nrm(k, shape, scale):
        return jax.random.normal(k, shape, f32) * scale

    return {
        'x': nrm(ks[0], (BATCH, SEQ, D_MODEL), 1.0),
        'c': nrm(ks[1], (BATCH, D_MODEL), 1.0),
        'ada_w': nrm(ks[2], (DEPTH, D_MODEL, 6 * D_MODEL), 0.5 * D_MODEL ** -0.5),
        'ada_b': nrm(ks[3], (DEPTH, 6 * D_MODEL), 0.01),
        'norm1_g': 1.0 + nrm(ks[4], (DEPTH, D_MODEL), 0.02),
        'w_in': nrm(ks[5], (DEPTH, D_MODEL, IN_COLS), D_MODEL ** -0.5),
        'lb_gamma': nrm(ks[6], (DEPTH + 1, HGRN_WIDTH), 0.1),
        'hgrn_norm_g': 1.0 + nrm(ks[7], (DEPTH, HGRN_WIDTH), 0.02),
        'gmlp_ln_g': 1.0 + nrm(ks[8], (DEPTH, GMLP_WIDTH), 0.02),
        'gmlp_ln_b': nrm(ks[9], (DEPTH, GMLP_WIDTH), 0.02),
        'spatial_w': nrm(ks[10], (DEPTH, GMLP_GROUPS, GMLP_CHUNK, GMLP_CHUNK), GMLP_CHUNK ** -0.5),
        'spatial_b': 1.0 + nrm(ks[11], (DEPTH, GMLP_GROUPS, GMLP_CHUNK), 0.02),
        'gmlp_norm_g': 1.0 + nrm(ks[12], (DEPTH, GMLP_WIDTH), 0.02),
        'w_out': nrm(ks[13], (DEPTH, MIX_WIDTH, D_MODEL), MIX_WIDTH ** -0.5),
        'norm2_g': 1.0 + nrm(ks[14], (DEPTH, D_MODEL), 0.02),
        'peer_wq': nrm(ks[15], (DEPTH, D_MODEL, PEER_HEADS * PEER_QUERY_DIM), D_MODEL ** -0.5),
        'peer_keys': nrm(ks[16], (DEPTH, PEER_HEADS, 2, PEER_N_KEYS, PEER_HALF), PEER_HALF ** -0.5),
        'peer_u': nrm(ks[17], (DEPTH, PEER_N_EXPERTS, D_MODEL), D_MODEL ** -0.5),
        'peer_v': nrm(ks[18], (DEPTH, PEER_N_EXPERTS, D_MODEL), 0.5),
        'final_g': 1.0 + nrm(ks[19], (D_MODEL,), 0.02),
    }


def reference(x, c, ada_w, ada_b, norm1_g, w_in, lb_gamma, hgrn_norm_g, gmlp_ln_g, gmlp_ln_b,
              spatial_w, spatial_b, gmlp_norm_g, w_out, norm2_g, peer_wq, peer_keys, peer_u, peer_v, final_g):
    lower_bounds = jnp.cumsum(jax.nn.softmax(lb_gamma.astype(jnp.float32), axis=0), axis=0)
    c_act = jax.nn.silu(c)
    for l in range(DEPTH):
        mod = c_act @ ada_w[l] + ada_b[l]
        shift1, scale1, gate1, shift2, scale2, gate2 = [m[:, None, :] for m in jnp.split(mod, 6, axis=-1)]
        h = rmsnorm(x, norm1_g[l]) * (1 + scale1) + shift1
        x = x + gate1 * hybrid_mixer(h, w_in[l], lower_bounds[l], hgrn_norm_g[l], gmlp_ln_g[l], gmlp_ln_b[l],
                                     spatial_w[l], spatial_b[l], gmlp_norm_g[l], w_out[l])
        h = rmsnorm(x, norm2_g[l]) * (1 + scale2) + shift2
        x = x + gate2 * peer_ffn(h, peer_wq[l], peer_keys[l], peer_u[l], peer_v[l])
    return rmsnorm(x, final_g)
```

```cpp
#include <hip/hip_runtime.h>
#include <cstdio>
#include <cstdint>
namespace pg8 {
#define PG8_LAS __attribute__((address_space(3)))
typedef unsigned short bf16_t;
typedef short bf16x8 __attribute__((ext_vector_type(8)));
typedef float f32x4 __attribute__((ext_vector_type(4)));
typedef unsigned u32x4 __attribute__((ext_vector_type(4)));
constexpr int BM = 256, BK = 64, HALF = 128, HTB = HALF * BK * 2  , STAGE_BYTES = 8 * HTB, NXCD = 8, WGM = 8;

__host__ __device__ __forceinline__ int lds_byte(int r, int c) { const int st = (r >> 4) * 2 + (c >> 5), rr = r & 15, cc = c & 31, ob = rr * 64 + cc * 2; return st * 1024 + (ob ^ (((ob >> 9) & 1) << 5)); }
__host__ __device__ __forceinline__ void stage_rc(int b, int& R, int& C) { const int st = b / 1024, sb = b % 1024, swz = sb ^ (((sb >> 9) & 1) << 5); R = (st >> 1) * 16 + swz / 64; C = (st & 1) * 32 + (swz % 64) / 2; }
__host__ __device__ __forceinline__ int perm32(int rho) { const int n = rho >> 4, i = rho & 15; return 8 * (i >> 2) + 4 * n + (i & 3); }

struct Unit { int pm, pn; };
struct Gemm { const bf16_t* A; const bf16_t* Bt; int M, N, K; int bsh = -1; };

struct StaticOrder {
    int nM, nN, nwg, G, c;
    __host__ __device__ void init(int M, int N, int G_, int c_) { nM = M / BM; nN = N / BM; nwg = nM * nN; G = G_; c = c_; }
    __host__ __device__ bool next(int i, Unit& u) const {
        const long L = (long)i * G + c; if (L >= nwg) return false;
        int wgid = (int)L; { const int q = nwg / NXCD, r = nwg % NXCD, xcd = wgid % NXCD, off = wgid / NXCD; wgid = (xcd < r ? xcd * (q + 1) : r * (q + 1) + (xcd - r) * q) + off; }
        const int nig = WGM * nN, gid = wgid / nig, fm = gid * WGM, gsz = (nM - fm) < WGM ? (nM - fm) : WGM;
        u.pm = fm + ((wgid % nig) % gsz); u.pn = (wgid % nig) / gsz; return true;
    }
    __device__ __forceinline__ void a_ready(const Unit&) const {}
    __device__ __forceinline__ void done(const Unit&) const {}
};

__device__ __forceinline__ unsigned cvt_pk_bf16(float lo, float hi) { unsigned r; asm volatile("v_cvt_pk_bf16_f32 %0, %1, %2" : "=v"(r) : "v"(lo), "v"(hi)); return r; }
typedef float f32x2 __attribute__((ext_vector_type(2)));

struct EpiBf16 {
    static constexpr bool PERM = true, AFTER_DRAIN = false;
    bf16_t* O; int ldc;
    __device__ __forceinline__ void operator()(const f32x4 (&acc)[2][2][4][2], const Unit& u, int wr, int wc, int fr, int fq) const {
        const int row0 = u.pm * BM + wr * 64 + fr; const int col0 = u.pn * BM + wc * 32 + 8 * fq;
#pragma unroll
        for (int ai = 0; ai < 2; ++ai)
#pragma unroll
            for (int m = 0; m < 4; ++m) { bf16_t* rowp = O + (size_t)(row0 + ai * HALF + m * 16) * ldc + col0;
#pragma unroll
                for (int bj = 0; bj < 2; ++bj) { const f32x4 v0 = acc[ai][bj][m][0], v1 = acc[ai][bj][m][1];
                    u32x4 w; w.x = cvt_pk_bf16(v0[0], v0[1]); w.y = cvt_pk_bf16(v0[2], v0[3]); w.z = cvt_pk_bf16(v1[0], v1[1]); w.w = cvt_pk_bf16(v1[2], v1[3]);
                    *(u32x4*)(rowp + bj * HALF) = w; } }
    }
};
struct EpiBf16S {
    static constexpr bool PERM = true, AFTER_DRAIN = false;
    bf16_t* O; int ldc; const float* sa; const float* sw;
    __device__ __forceinline__ void operator()(const f32x4 (&acc)[2][2][4][2], const Unit& u, int wr, int wc, int fr, int fq) const {
        const int row0 = u.pm * BM + wr * 64 + fr; const int col0 = u.pn * BM + wc * 32 + 8 * fq;
        f32x4 cs[2][2];
#pragma unroll
        for (int bj = 0; bj < 2; ++bj)
#pragma unroll
            for (int n = 0; n < 2; ++n) cs[bj][n] = *(const f32x4*)(sw + col0 + bj * HALF + 4 * n);
#pragma unroll
        for (int ai = 0; ai < 2; ++ai)
#pragma unroll
            for (int m = 0; m < 4; ++m) { const int row = row0 + ai * HALF + m * 16; const float rs = sa[row]; bf16_t* rowp = O + (size_t)row * ldc + col0;
#pragma unroll
                for (int bj = 0; bj < 2; ++bj) { const f32x4 v0 = acc[ai][bj][m][0] * cs[bj][0] * rs, v1 = acc[ai][bj][m][1] * cs[bj][1] * rs;
                    u32x4 w; w.x = cvt_pk_bf16(v0[0], v0[1]); w.y = cvt_pk_bf16(v0[2], v0[3]); w.z = cvt_pk_bf16(v1[0], v1[1]); w.w = cvt_pk_bf16(v1[2], v1[3]);
                    *(u32x4*)(rowp + bj * HALF) = w; } }
    }
};
struct EpiResid {
    static constexpr bool PERM = true, AFTER_DRAIN = false;
    const float* xin; bf16_t* out; const float* gate; int gate_stride; int rows_per_batch; int ldc; float* ssq;
    __device__ __forceinline__ void operator()(const f32x4 (&acc)[2][2][4][2], const Unit& u, int wr, int wc, int fr, int fq) const {
        const int row0 = u.pm * BM + wr * 64 + fr; const int col0 = u.pn * BM + wc * 32 + 8 * fq;
        const float* gp = gate + (size_t)((u.pm * BM) / rows_per_batch) * gate_stride + col0;
        f32x4 gv[2][2];
#pragma unroll
        for (int bj = 0; bj < 2; ++bj)
#pragma unroll
            for (int n = 0; n < 2; ++n) gv[bj][n] = *(const f32x4*)(gp + bj * HALF + 4 * n);
#pragma unroll
        for (int ai = 0; ai < 2; ++ai)
#pragma unroll
            for (int m = 0; m < 4; ++m) { const int row = row0 + ai * HALF + m * 16; const size_t off = (size_t)row * ldc + col0; float s2 = 0.f;
#pragma unroll
                for (int bj = 0; bj < 2; ++bj) { const f32x4 x0 = *(const f32x4*)(xin + off + bj * HALF), x1 = *(const f32x4*)(xin + off + bj * HALF + 4);
                    const f32x4 v0 = x0 + gv[bj][0] * acc[ai][bj][m][0], v1 = x1 + gv[bj][1] * acc[ai][bj][m][1];
                    s2 += (v0[0] * v0[0] + v0[1] * v0[1]) + (v0[2] * v0[2] + v0[3] * v0[3]) + (v1[0] * v1[0] + v1[1] * v1[1]) + (v1[2] * v1[2] + v1[3] * v1[3]);
                    u32x4 w; w.x = cvt_pk_bf16(v0[0], v0[1]); w.y = cvt_pk_bf16(v0[2], v0[3]); w.z = cvt_pk_bf16(v1[0], v1[1]); w.w = cvt_pk_bf16(v1[2], v1[3]);
                    *(u32x4*)(out + off + bj * HALF) = w; }
                s2 += __shfl_xor(s2, 16); s2 += __shfl_xor(s2, 32);
                if (fq == 0) ssq[(size_t)row * 16 + u.pn * 4 + wc] = s2; }
    }
};
struct EpiQ {
    static constexpr bool PERM = true, AFTER_DRAIN = false;
    bf16_t* O; int ldc; const float* ssq; const float* bias; int bsh;
    __device__ __forceinline__ void operator()(const f32x4 (&acc)[2][2][4][2], const Unit& u, int wr, int wc, int fr, int fq) const {
        const int row0 = u.pm * BM + wr * 64 + fr; const int col0 = u.pn * BM + wc * 32 + 8 * fq;
        const float* bp = bias + (size_t)(u.pm >> bsh) * ldc + col0;
        f32x4 bv[2][2];
#pragma unroll
        for (int bj = 0; bj < 2; ++bj)
#pragma unroll
            for (int n = 0; n < 2; ++n) bv[bj][n] = *(const f32x4*)(bp + bj * HALF + 4 * n);
#pragma unroll
        for (int ai = 0; ai < 2; ++ai)
#pragma unroll
            for (int m = 0; m < 4; ++m) { const int row = row0 + ai * HALF + m * 16; const f32x4* sp = (const f32x4*)(ssq + (size_t)row * 16);
                const f32x4 sa = (sp[0] + sp[1]) + (sp[2] + sp[3]); const float rs = __builtin_amdgcn_rsqf(((sa[0] + sa[1]) + (sa[2] + sa[3])) * (1.f / 1024.f) + 1e-6f);
                bf16_t* rowp = O + (size_t)row * ldc + col0;
#pragma unroll
                for (int bj = 0; bj < 2; ++bj) { const f32x4 v0 = acc[ai][bj][m][0] * rs + bv[bj][0], v1 = acc[ai][bj][m][1] * rs + bv[bj][1];
                    u32x4 w; w.x = cvt_pk_bf16(v0[0], v0[1]); w.y = cvt_pk_bf16(v0[2], v0[3]); w.z = cvt_pk_bf16(v1[0], v1[1]); w.w = cvt_pk_bf16(v1[2], v1[3]);
                    *(u32x4*)(rowp + bj * HALF) = w; } }
    }
};

typedef int i32x4 __attribute__((ext_vector_type(4)));
template <bool I8> __device__ __forceinline__ f32x4 mma16(const bf16x8 b, const bf16x8 a, const f32x4 c) {
    if constexpr (I8) return __builtin_bit_cast(f32x4, __builtin_amdgcn_mfma_i32_16x16x64_i8(__builtin_bit_cast(i32x4, b), __builtin_bit_cast(i32x4, a), __builtin_bit_cast(i32x4, c), 0, 0, 0));
    else return __builtin_amdgcn_mfma_f32_16x16x32_bf16(b, a, c, 0, 0, 0);
}
template <class Epi, class Sched, bool ALIGN_EPI = false, bool SP2 = false, bool I8 = false>
__device__ __forceinline__ void gemm_phase(PG8_LAS unsigned char* lds, const Gemm g, const Sched& S, const Epi& E) {
    const int tid = threadIdx.x, wid = __builtin_amdgcn_readfirstlane(tid >> 6), lane = tid & 63, wr = wid >> 2, wc = wid & 3, fr = lane & 15, fq = lane >> 4;
    const int K = g.K, nt = K / BK;
    unsigned voffA[2], voffB[2];
#pragma unroll
    for (int i = 0; i < 2; ++i) { int R, C; stage_rc(tid * 16 + i * 8192, R, C); const int Rb = Epi::PERM ? ((R & ~31) + perm32(R & 31)) : R;
        voffA[i] = (unsigned)(R * K + C) * 2u; voffB[i] = (unsigned)(Rb * K + C) * 2u; }
    const size_t kstep = (size_t)(BK * 2);
    const size_t hstep = (size_t)HALF * K * 2;
    const size_t tstep = 2 * hstep;
    const unsigned ldsw = (unsigned)wid * 1024u;
    const int aoff = lds_byte(wr * 64 + fr, fq * 8), boff = lds_byte(wc * 32 + fr, fq * 8);
#define PG8_SA(b, h) (((b) * 2 + (h)) * HTB)
#define PG8_SB(b, h) ((4 + (b) * 2 + (h)) * HTB)
#define PG8_STAGE(bufoff, gbase, voff) do { _Pragma("unroll") for (int _i = 0; _i < 2; ++_i) \
        __builtin_amdgcn_global_load_lds((const unsigned*)((const char*)(gbase) + (voff)[_i]), (PG8_LAS unsigned*)(lds + (bufoff) + ldsw + _i * 8192), 16, 0, 0); } while (0)
#define PG8_LDA(dst, b, h) do { _Pragma("unroll") for (int m = 0; m < 4; ++m) _Pragma("unroll") for (int k = 0; k < 2; ++k) dst[m][k] = *(const PG8_LAS bf16x8*)(lds + PG8_SA(b, h) + aoff + m * 2048 + k * 1024); } while (0)
#define PG8_LDB(dst, b, h) do { _Pragma("unroll") for (int n = 0; n < 2; ++n) _Pragma("unroll") for (int k = 0; k < 2; ++k) dst[n][k] = *(const PG8_LAS bf16x8*)(lds + PG8_SB(b, h) + boff + n * 2048 + k * 1024); } while (0)
#define PG8_MMA(ai, bj, At, Bt) do { __builtin_amdgcn_s_setprio(1); _Pragma("unroll") for (int m = 0; m < 4; ++m) _Pragma("unroll") for (int n = 0; n < 2; ++n) _Pragma("unroll") for (int k = 0; k < 2; ++k) \
        acc[ai][bj][m][n] = mma16<I8>(Bt[n][k], At[m][k], acc[ai][bj][m][n]); __builtin_amdgcn_s_setprio(0); } while (0)
#define PG8_WAIT_V(n) asm volatile("s_waitcnt vmcnt(" #n ")" ::: "memory")
#define PG8_WAIT_L(n) asm volatile("s_waitcnt lgkmcnt(" #n ")" ::: "memory")
#define PG8_BAR __builtin_amdgcn_s_barrier()
#define PG8_SCHED __builtin_amdgcn_sched_barrier(0)
    Unit cur, nxt; int ui = 0;
    if (!S.next(0, cur)) return;
    f32x4 acc[2][2][4][2];
#pragma unroll
    for (int a = 0; a < 2; ++a)
#pragma unroll
        for (int b = 0; b < 2; ++b)
#pragma unroll
            for (int m = 0; m < 4; ++m)
#pragma unroll
                for (int n = 0; n < 2; ++n) acc[a][b][m][n] = (f32x4){0.f, 0.f, 0.f, 0.f};
    bf16x8 At[4][2], B0[2][2], B1[2][2];
    const char* cA = (const char*)g.A + (size_t)cur.pm * tstep; const char* cB = (const char*)g.Bt + (size_t)(cur.pn + (g.bsh >= 0 ? (cur.pm >> g.bsh) * (g.N / BM) : 0)) * tstep;
    S.a_ready(cur);
    if constexpr (SP2) {
        PG8_STAGE(PG8_SB(0, 0), cB, voffB); PG8_STAGE(PG8_SB(0, 1), cB + hstep, voffB); PG8_STAGE(PG8_SA(0, 0), cA, voffA); PG8_STAGE(PG8_SA(0, 1), cA + hstep, voffA);
        if (wr == 1) PG8_BAR;
        PG8_WAIT_V(2); PG8_BAR;
        PG8_STAGE(PG8_SB(1, 0), cB + kstep, voffB); PG8_STAGE(PG8_SA(1, 0), cA + kstep, voffA); PG8_STAGE(PG8_SB(1, 1), cB + hstep + kstep, voffB);
        PG8_WAIT_V(6); PG8_BAR;
    } else {
        PG8_STAGE(PG8_SB(0, 0), cB, voffB); PG8_STAGE(PG8_SA(0, 0), cA, voffA); PG8_STAGE(PG8_SB(0, 1), cB + hstep, voffB); PG8_STAGE(PG8_SA(0, 1), cA + hstep, voffA);
        if (wr == 1) PG8_BAR;
        PG8_WAIT_V(4); PG8_BAR;
        PG8_STAGE(PG8_SB(1, 0), cB + kstep, voffB); PG8_STAGE(PG8_SA(1, 0), cA + kstep, voffA); PG8_STAGE(PG8_SB(1, 1), cB + hstep + kstep, voffB);
        PG8_WAIT_V(6); PG8_BAR;
    }
    for (;;) {
        const bool has_next = S.next(ui + 1, nxt);
        const char* nA = has_next ? (const char*)g.A + (size_t)nxt.pm * tstep : cA; const char* nB = has_next ? (const char*)g.Bt + (size_t)(nxt.pn + (g.bsh >= 0 ? (nxt.pm >> g.bsh) * (g.N / BM) : 0)) * tstep : cB;
        for (int t = 0; t < nt; t += 2) {
            const bool last = (t == nt - 2);
            const char* a1 = cA + (size_t)(t + 1) * kstep;
            const char* a2 = last ? nA : cA + (size_t)(t + 2) * kstep; const char* b2 = last ? nB : cB + (size_t)(t + 2) * kstep;
            const char* a3 = a2 + kstep; const char* b3 = b2 + kstep;
            if (last && has_next) S.a_ready(nxt);
            if constexpr (SP2) {
            PG8_LDB(B0, 0, 0); PG8_LDB(B1, 0, 1); PG8_SCHED; PG8_LDA(At, 0, 0); PG8_STAGE(PG8_SA(1, 1), a1 + hstep, voffA);
            PG8_WAIT_V(8); PG8_WAIT_L(0); PG8_BAR; PG8_MMA(0, 0, At, B0); PG8_MMA(0, 1, At, B1); PG8_BAR; PG8_SCHED;
            PG8_LDA(At, 0, 1); PG8_STAGE(PG8_SB(0, 0), b2, voffB); PG8_STAGE(PG8_SB(0, 1), b2 + hstep, voffB); PG8_STAGE(PG8_SA(0, 0), a2, voffA);
            PG8_WAIT_V(8); PG8_WAIT_L(0); PG8_BAR; PG8_MMA(1, 0, At, B0); PG8_MMA(1, 1, At, B1); PG8_BAR; PG8_SCHED;
            PG8_LDB(B0, 1, 0); PG8_LDB(B1, 1, 1); PG8_SCHED; PG8_LDA(At, 1, 0); PG8_STAGE(PG8_SA(0, 1), a2 + hstep, voffA);
            PG8_WAIT_V(8); PG8_WAIT_L(0); PG8_BAR; PG8_MMA(0, 0, At, B0); PG8_MMA(0, 1, At, B1); PG8_BAR; PG8_SCHED;
            PG8_LDA(At, 1, 1); PG8_STAGE(PG8_SB(1, 0), b3, voffB); PG8_STAGE(PG8_SB(1, 1), b3 + hstep, voffB); PG8_STAGE(PG8_SA(1, 0), a3, voffA);
            PG8_WAIT_V(8); PG8_WAIT_L(0); PG8_BAR; PG8_MMA(1, 0, At, B0); PG8_MMA(1, 1, At, B1); PG8_BAR; PG8_SCHED;
            } else {
            PG8_LDB(B0, 0, 0); PG8_SCHED; PG8_LDA(At, 0, 0); PG8_STAGE(PG8_SA(1, 1), a1 + hstep, voffA);
            PG8_WAIT_L(8); PG8_BAR; PG8_WAIT_L(0); PG8_MMA(0, 0, At, B0); PG8_BAR; PG8_SCHED;
            PG8_LDB(B1, 0, 1); PG8_STAGE(PG8_SB(0, 0), b2, voffB);
            PG8_BAR; PG8_WAIT_L(0); PG8_MMA(0, 1, At, B1); PG8_BAR;
            PG8_LDA(At, 0, 1); PG8_STAGE(PG8_SA(0, 0), a2, voffA);
            PG8_BAR; PG8_WAIT_L(0); PG8_MMA(1, 0, At, B0); PG8_BAR; PG8_SCHED;
            PG8_STAGE(PG8_SB(0, 1), b2 + hstep, voffB);
            PG8_WAIT_V(6); PG8_BAR; PG8_MMA(1, 1, At, B1); PG8_BAR;
            PG8_LDB(B0, 1, 0); PG8_SCHED; PG8_LDA(At, 1, 0); PG8_STAGE(PG8_SA(0, 1), a2 + hstep, voffA);
            PG8_WAIT_L(8); PG8_BAR; PG8_WAIT_L(0); PG8_MMA(0, 0, At, B0); PG8_BAR; PG8_SCHED;
            PG8_LDB(B1, 1, 1); PG8_STAGE(PG8_SB(1, 0), b3, voffB);
            PG8_BAR; PG8_WAIT_L(0); PG8_MMA(0, 1, At, B1); PG8_BAR;
            PG8_LDA(At, 1, 1); PG8_STAGE(PG8_SA(1, 0), a3, voffA);
            PG8_BAR; PG8_WAIT_L(0); PG8_MMA(1, 0, At, B0); PG8_BAR; PG8_SCHED;
            PG8_STAGE(PG8_SB(1, 1), b3 + hstep, voffB);
            PG8_WAIT_V(6); PG8_BAR; PG8_MMA(1, 1, At, B1); PG8_BAR;
            }
        }
        if constexpr (ALIGN_EPI) { if (wr == 0) PG8_BAR; }
        if constexpr (I8) {
#pragma unroll
            for (int a = 0; a < 2; ++a)
#pragma unroll
                for (int b = 0; b < 2; ++b)
#pragma unroll
                    for (int m = 0; m < 4; ++m)
#pragma unroll
                        for (int n = 0; n < 2; ++n) acc[a][b][m][n] = __builtin_convertvector(__builtin_bit_cast(i32x4, acc[a][b][m][n]), f32x4); }
        if constexpr (!Epi::AFTER_DRAIN) { E(acc, cur, wr, wc, fr, fq); S.done(cur); }
        if (!has_next) break;
#pragma unroll
        for (int a = 0; a < 2; ++a)
#pragma unroll
            for (int b = 0; b < 2; ++b)
#pragma unroll
                for (int m = 0; m < 4; ++m)
#pragma unroll
                    for (int n = 0; n < 2; ++n) acc[a][b][m][n] = (f32x4){0.f, 0.f, 0.f, 0.f};
        cur = nxt; cA = nA; cB = nB; ++ui;
        if constexpr (ALIGN_EPI) { if (wr == 1) PG8_BAR; }
    }
    PG8_WAIT_V(0);
    if constexpr (!ALIGN_EPI) { if (wr == 0) PG8_BAR; }
    PG8_BAR;
    if constexpr (Epi::AFTER_DRAIN) { E.fused(acc, cur, wr, wc, fr, fq, lds, wid, lane); S.done(cur); }
#undef PG8_SA
#undef PG8_SB
#undef PG8_STAGE
#undef PG8_LDA
#undef PG8_LDB
#undef PG8_MMA
#undef PG8_WAIT_V
#undef PG8_WAIT_L
#undef PG8_BAR
#undef PG8_SCHED
}
}


constexpr int NB = 4, SEQ = 8192, DM = 1024, T = NB * SEQ;
constexpr int NPROJ = 3072, HW = 512, HD = 128, HCH = 64;
constexpr int PH = 8, NQ = 2048;
constexpr float EPS = 1e-6f;
constexpr int NWAVES = 8;
#ifndef G1_I8
#define G1_I8 1
#endif
#ifndef G3_I8
#define G3_I8 0
#endif
static_assert(G3_I8 == 0, "the folded second rmsnorm (query GEMM on x1 with per-batch folded weights) is written for the bf16 query GEMM");
#ifndef P10_U4
#define P10_U4 1
#endif
#ifndef P10_V4
#define P10_V4 1
#endif
static_assert(P10_U4 == P10_V4, "the record layouts below are all-8-bit or all-4-bit");
constexpr int P10_UB = P10_U4 ? 512 : 1024, P10_REC = P10_U4 ? 1152 : 2048;
#ifndef MK_PER_PHASE
#define MK_PER_PHASE 0
#endif
constexpr int NPHASE = 11;

constexpr size_t MiB = 1u << 20;
constexpr size_t WS_CTL = 0, CTL_ZERO_BYTES = 1 * MiB;
constexpr size_t WS_MODP = 1 * MiB;
constexpr size_t WS_MOD = 1 * MiB + 800 * 1024;
constexpr size_t WS_LB = 1 * MiB + 900 * 1024;
constexpr size_t WS_SW = 1 * MiB + 910 * 1024;
constexpr size_t WS_SA = 498 * MiB;
constexpr int CW_COLMAX = 65536;
constexpr size_t WS_WIN = 2 * MiB, WS_WOUT = 8 * MiB, WS_WQ = 10 * MiB, WS_KEYS = 14 * MiB, WS_SPW = 15 * MiB;
constexpr size_t WS_UT = 16 * MiB, WS_VT = 32 * MiB;
constexpr size_t WS_USC = 48 * MiB, WS_VSC = 48 * MiB + 65536;
constexpr size_t WS_QBIAS = 52 * MiB;
constexpr size_t WS_GM = 52 * MiB + 65536;
constexpr size_t WS_SSQ = 53 * MiB;
constexpr size_t WS_WQF = 56 * MiB;
constexpr size_t WS_XN = 80 * MiB;
constexpr size_t WS_PROJ = 144 * MiB;
constexpr size_t WS_STATE = 336 * MiB;
constexpr size_t WS_X1 = 272 * MiB;
constexpr size_t WS_DEC = 400 * MiB;
constexpr size_t WS_CAT = 402 * MiB;
constexpr size_t WS_IDX = 466 * MiB, WS_GATE = 482 * MiB;
constexpr size_t WS_END = 499 * MiB;
constexpr int CW_BAR = 4096;

constexpr int RING_BYTES = 131072;
constexpr int LDSCTL_OFF = RING_BYTES, MISC_OFF = LDSCTL_OFF + 320;
constexpr int LDS_BYTES = 147456;
constexpr int LDS_SPARE = 135168;

#define GAS __attribute__((address_space(1)))
#define LAS __attribute__((address_space(3)))
typedef unsigned short bf16;
typedef unsigned v4u __attribute__((ext_vector_type(4)));
typedef unsigned v2u __attribute__((ext_vector_type(2)));
typedef float f32x4 __attribute__((ext_vector_type(4)));
typedef float f32x16 __attribute__((ext_vector_type(16)));
typedef float f32x2 __attribute__((ext_vector_type(2)));
typedef int i32x4 __attribute__((ext_vector_type(4)));
typedef short bf16x8 __attribute__((ext_vector_type(8)));
typedef GAS unsigned gu32;
#define LDS_WAIT() asm volatile("s_waitcnt lgkmcnt(0)" ::: "memory")
#define VM_WAIT() asm volatile("s_waitcnt vmcnt(0)" ::: "memory")
__device__ __forceinline__ unsigned pk2(float lo, float hi) { unsigned r; asm("v_cvt_pk_bf16_f32 %0, %1, %2" : "=v"(r) : "v"(lo), "v"(hi)); return r; }
__device__ __forceinline__ unsigned f2bf(float f) { return pk2(f, 0.f) & 0xffffu; }
__device__ __forceinline__ unsigned f2bf_sw(float f) { unsigned u = __builtin_bit_cast(unsigned, f); return (u + 0x7fffu + ((u >> 16) & 1u)) >> 16; }
__device__ __forceinline__ unsigned pk2_sw(float lo, float hi) { return f2bf_sw(lo) | (f2bf_sw(hi) << 16); }
__device__ __forceinline__ float bf2f(unsigned short h) { return __uint_as_float((unsigned)h << 16); }
__device__ __forceinline__ float bflo(unsigned w) { return __uint_as_float(w << 16); }
__device__ __forceinline__ float bfhi(unsigned w) { return __uint_as_float(w & 0xffff0000u); }
__device__ __forceinline__ float rcp_f(float x) { return __builtin_amdgcn_rcpf(x); }
__device__ __forceinline__ float rsq_f(float x) { return __builtin_amdgcn_rsqf(x); }
__device__ __forceinline__ float silu_f(float x) { return x * rcp_f(1.f + __expf(-x)); }
__device__ __forceinline__ float gelu_div(float x) { const float z = 0.7978845608f * (x + 0.044715f * x * x * x); const float e = __expf(2.f * z); return x * (1.f - 1.f / (1.f + e)); }
__device__ __forceinline__ float gelu_fast(float x) { const float e = __builtin_amdgcn_exp2f(2.3022082f * (x + 0.044715f * x * x * x)); return x * (1.f - __builtin_amdgcn_rcpf(1.f + e)); }
__device__ __forceinline__ float gelu_f(float x) { const float z = 0.7978845608f * (x + 0.044715f * x * x * x); const float e = __expf(2.f * z); return x * (1.f - rcp_f(1.f + e)); }

#define XB_TMO      128
#define XB_XCNT(j)  (256  + 64 * (j))
#define XB_XSUB(j)  (1280 + 64 * (j))
#define XB_XGEN(j)  (2304 + 64 * (j))
#define XB_TOP      3328
#define XB_TOPGEN   3392
#define XCD_BAR_WORDS 3456
#define XB_SPIN_CAP (1u << 18)

__device__ __forceinline__ unsigned xb_ld(unsigned* p)              { return __hip_atomic_load(p, __ATOMIC_RELAXED, __HIP_MEMORY_SCOPE_AGENT); }
__device__ __forceinline__ unsigned xb_add(unsigned* p, unsigned v) { return __hip_atomic_fetch_add(p, v, __ATOMIC_RELAXED, __HIP_MEMORY_SCOPE_AGENT); }
__device__ __forceinline__ unsigned xb_xcc_id() { return (unsigned)__builtin_amdgcn_s_getreg((3 << 11) | 20) & 0xFu; }
#define XB_SPIN(cond, bar) do { unsigned _sp = 0; while (cond) { __builtin_amdgcn_s_sleep(1); \
    if ((++_sp & 255u) == 0u) { if (xb_ld(&(bar)[XB_TMO])) break; if (_sp > XB_SPIN_CAP) { atomicAdd(&(bar)[XB_TMO], 1u); break; } } } } while (0)

struct XcdBarrier {
    unsigned* bar; unsigned x;
    volatile LAS unsigned* st;
};

__device__ __forceinline__ XcdBarrier xcd_barrier_post(unsigned* bar, volatile LAS unsigned* st) {
    XcdBarrier b; b.bar = bar; b.x = xb_xcc_id(); b.st = st;
    if (threadIdx.x == 0) (void)xb_add(&bar[XB_XCNT(b.x)], 1u);
    return b;
}
__device__ __forceinline__ void xcd_barrier_complete(unsigned* bar, unsigned x, unsigned& nloc, unsigned& nx) {
    const unsigned G = gridDim.x * gridDim.y * gridDim.z;
    unsigned sum, cnt, mine, sp = 0u;
    for (;;) {
        sum = 0u; cnt = 0u; mine = 0u;
#pragma unroll
        for (unsigned j = 0; j < 16; ++j) { const unsigned c = xb_ld(&bar[XB_XCNT(j)]); sum += c; cnt += (c > 0u) ? 1u : 0u; mine = (j == x) ? c : mine; }
        if (sum == G) break;
        __builtin_amdgcn_s_sleep(1);
        if ((++sp & 255u) == 0u) { if (xb_ld(&bar[XB_TMO])) break; if (sp > XB_SPIN_CAP) { atomicAdd(&bar[XB_TMO], 1u); break; } }
    }
    nloc = mine > 0u ? mine : 1u; nx = cnt > 0u ? cnt : 1u;
}

__device__ __forceinline__ void xcd_barrier(const XcdBarrier& b) {
    asm volatile("s_waitcnt vmcnt(0)" ::: "memory");
    __syncthreads();
    if (threadIdx.x == 0) {
        unsigned* bar = b.bar;
        __builtin_amdgcn_s_waitcnt(0);
        unsigned nloc = b.st[0], nx = b.st[1];
        if (nloc == 0u) { xcd_barrier_complete(bar, b.x, nloc, nx); b.st[0] = nloc; b.st[1] = nx; }
        const unsigned old = xb_add(&bar[XB_XSUB(b.x)], 1u);
        const unsigned gen = old / nloc;
        if (old + 1u == (gen + 1u) * nloc) {
            __builtin_amdgcn_fence(__ATOMIC_RELEASE, "agent");
            asm volatile("s_waitcnt vmcnt(0)" ::: "memory");
            const unsigned og = xb_add(&bar[XB_TOP], 1u);
            const unsigned tg = og / nx;
            if (og + 1u == (tg + 1u) * nx) xb_add(&bar[XB_TOPGEN], 1u);
            else XB_SPIN(xb_ld(&bar[XB_TOPGEN]) == tg, bar);
            __builtin_amdgcn_fence(__ATOMIC_ACQUIRE, "agent");
            xb_add(&bar[XB_XGEN(b.x)], 1u);
            asm volatile("s_waitcnt vmcnt(0)" ::: "memory");
        } else {
            XB_SPIN(xb_ld(&bar[XB_XGEN(b.x)]) == gen, bar);
            __builtin_amdgcn_fence(__ATOMIC_ACQUIRE, "agent");
            asm volatile("s_waitcnt vmcnt(0)" ::: "memory");
        }
    }
    __syncthreads();
}


struct Frame {
    LAS unsigned char* lds;
    volatile LAS unsigned* MISC;
    gu32* ctl;
    int tid, lane, wave, vcu, G;
    const float *x, *c, *ada_w, *ada_b, *norm1_g, *w_in, *lb_gamma, *hgrn_g, *ln_g, *ln_b, *sp_w, *sp_b, *gm_g, *w_out, *norm2_g, *wq, *keys, *pu, *pv, *final_g;
    float* out;
    float *MODP, *MOD, *LB, *DEC, *GATE, *SW, *SA, *QBIAS, *GM, *SSQ; bf16 *X1, *WQF;
    int* IDX;
    bf16 *WIN, *WOUT, *WQ, *KEYS, *SPW, *XN, *PROJ, *QB, *STATE, *CAT;
    unsigned char *UT, *VT; float *USC, *VSC;
};

__device__ __forceinline__ float wave_sum(float v) {
#pragma unroll
    for (int o = 1; o < 64; o <<= 1) v += __shfl_xor(v, o);
    return v;
}
__device__ __forceinline__ void p0_transpose_item(const float* W, int K, int N, bf16* WT, int row_off, LAS float* scr, int item, int lane) {
    const int nblk = N / 32, kb = item / nblk, nb = item % nblk, k0 = 64 * kb, n0 = 32 * nb;
#pragma unroll
    for (int i = 0; i < 32; ++i) { const int kk = 2 * i + (lane >> 5); scr[kk * 33 + (lane & 31)] = W[(size_t)(k0 + kk) * N + n0 + (lane & 31)]; }
    LDS_WAIT(); asm volatile("" ::: "memory");
    const int c = lane & 7;
#pragma unroll
    for (int j = 0; j < 4; ++j) { const int n = (lane >> 3) + 8 * j; const LAS float* s = scr + (8 * c) * 33 + n;
        v4u o; o.x = pk2(s[0 * 33], s[1 * 33]); o.y = pk2(s[2 * 33], s[3 * 33]); o.z = pk2(s[4 * 33], s[5 * 33]); o.w = pk2(s[6 * 33], s[7 * 33]);
        *(GAS v4u*)(WT + (size_t)(row_off + n0 + n) * K + k0 + 8 * c) = o; }
    LDS_WAIT(); asm volatile("" ::: "memory");
}
__device__ __forceinline__ void p1_fold_item(const float* W, int K, int N, bf16* WT, const LAS float* gm, LAS float* scr, int item, int lane) {
    const int nblk = N / 32, kb = item / nblk, nb = item % nblk, k0 = 64 * kb, n0 = 32 * nb;
#pragma unroll
    for (int i = 0; i < 32; ++i) { const int kk = 2 * i + (lane >> 5); scr[kk * 33 + (lane & 31)] = W[(size_t)(k0 + kk) * N + n0 + (lane & 31)] * gm[k0 + kk]; }
    LDS_WAIT(); asm volatile("" ::: "memory");
    const int c = lane & 7;
#pragma unroll
    for (int j = 0; j < 4; ++j) { const int n = (lane >> 3) + 8 * j; const LAS float* s = scr + (8 * c) * 33 + n;
        v4u o; o.x = pk2(s[0 * 33], s[1 * 33]); o.y = pk2(s[2 * 33], s[3 * 33]); o.z = pk2(s[4 * 33], s[5 * 33]); o.w = pk2(s[6 * 33], s[7 * 33]);
        *(GAS v4u*)(WT + (size_t)(n0 + n) * K + k0 + 8 * c) = o; }
    LDS_WAIT(); asm volatile("" ::: "memory");
}
__device__ __forceinline__ void p0_colmax_item(const float* W, int N, unsigned* colmax, int item, int lane) {
    const int nblk = N / 32, kb = item / nblk, nb = item % nblk, k0 = 64 * kb, n0 = 32 * nb; float m = 0.f;
#pragma unroll
    for (int i = 0; i < 32; ++i) { const int kk = 2 * i + (lane >> 5); m = fmaxf(m, fabsf(W[(size_t)(k0 + kk) * N + n0 + (lane & 31)])); }
    m = fmaxf(m, __shfl_xor(m, 32));
    if (lane < 32) atomicMax(colmax + n0 + lane, __float_as_uint(m));
}
__device__ __forceinline__ void p1_qtranspose_item(const float* W, int K, int N, unsigned char* WT, const unsigned* colmax, float* sw, LAS float* scr, int item, int lane) {
    const int nblk = N / 32, kb = item / nblk, nb = item % nblk, k0 = 64 * kb, n0 = 32 * nb;
#pragma unroll
    for (int i = 0; i < 32; ++i) { const int kk = 2 * i + (lane >> 5); scr[kk * 33 + (lane & 31)] = W[(size_t)(k0 + kk) * N + n0 + (lane & 31)]; }
    LDS_WAIT(); asm volatile("" ::: "memory");
    const int c = lane & 7;
#pragma unroll
    for (int j = 0; j < 4; ++j) { const int n = (lane >> 3) + 8 * j; const LAS float* sp = scr + (8 * c) * 33 + n;
        const float mx = __uint_as_float(__hip_atomic_load(colmax + n0 + n, __ATOMIC_RELAXED, __HIP_MEMORY_SCOPE_AGENT)), inv = mx > 0.f ? 127.f / mx : 0.f;
        unsigned lo = 0u, hi = 0u;
#pragma unroll
        for (int e = 0; e < 4; ++e) { lo |= ((unsigned)(int)rintf(sp[e * 33] * inv) & 0xffu) << (8 * e); hi |= ((unsigned)(int)rintf(sp[(4 + e) * 33] * inv) & 0xffu) << (8 * e); }
        *(GAS v2u*)(WT + (size_t)(n0 + n) * K + k0 + 8 * c) = (v2u){lo, hi};
        if (kb == 0 && c == 0) sw[n0 + n] = mx * (1.f / 127.f); }
    LDS_WAIT(); asm volatile("" ::: "memory");
}
__device__ __forceinline__ void cvt8(const float* src, bf16* dst) {
    const f32x4 a = *(const GAS f32x4*)src, b = *(const GAS f32x4*)(src + 4);
    v4u o; o.x = pk2(a.x, a.y); o.y = pk2(a.z, a.w); o.z = pk2(b.x, b.y); o.w = pk2(b.z, b.w);
    *(GAS v4u*)dst = o;
}

__device__ __forceinline__ void p0_prologue(Frame& F) {
    LAS float* cact = (LAS float*)(F.lds);
    LAS float* red = (LAS float*)(F.lds + 16384);
#pragma unroll
    for (int j = 0; j < 8; ++j) { const int i = F.tid + 512 * j; const float v = F.c[i]; cact[i] = v * rcp_f(1.f + __expf(-v)); }
    __syncthreads();
    for (int it = F.vcu; it < 192; it += F.G) {
        const int cg = it % 24, kg = it / 24, k0 = kg * 128 + F.wave * 16, col = cg * 256 + 4 * F.lane;
        f32x4 w[16];
#pragma unroll
        for (int i = 0; i < 16; ++i) w[i] = *(const GAS f32x4*)(F.ada_w + (size_t)(k0 + i) * 6144 + col);
        f32x4 a[4];
#pragma unroll
        for (int b = 0; b < 4; ++b) a[b] = (f32x4){0.f, 0.f, 0.f, 0.f};
#pragma unroll
        for (int i = 0; i < 16; ++i)
#pragma unroll
            for (int b = 0; b < 4; ++b) a[b] += w[i] * cact[b * 1024 + k0 + i];
#pragma unroll
        for (int b = 0; b < 4; ++b) *(LAS f32x4*)(red + (F.wave * 4 + b) * 256 + 4 * F.lane) = a[b];
        __syncthreads();
        for (int o = F.tid; o < 1024; o += 512) { float s = 0.f;
#pragma unroll
            for (int w8 = 0; w8 < 8; ++w8) s += red[w8 * 1024 + o];
            F.MODP[(size_t)(kg * 4 + (o >> 8)) * 6144 + cg * 256 + (o & 255)] = s; }
        __syncthreads();
    }
    {
        LAS float* scr = (LAS float*)(F.lds + F.wave * 16384);
        const int gw = F.vcu * NWAVES + F.wave, NGW = F.G * NWAVES;
        constexpr int I_IN = (DM / 64) * (NPROJ / 32), I_OUT = (DM / 64) * (DM / 32), I_Q = (DM / 64) * (NQ / 32);
        for (int it = gw; it < I_IN + I_OUT + (G3_I8 ? I_Q : 0); it += NGW) {
            int r = it;
            if (r < I_IN) { p0_colmax_item(F.w_in, NPROJ, (unsigned*)(F.ctl + CW_COLMAX), r, F.lane); continue; } r -= I_IN;
            if (r < I_OUT) { p0_transpose_item(F.w_out, DM, DM, F.WOUT, 0, scr, r, F.lane); continue; } r -= I_OUT;
            p0_colmax_item(F.wq, NQ, (unsigned*)(F.ctl + CW_COLMAX) + NPROJ, r, F.lane);
        }
    }
    const int gt = F.vcu * 512 + F.tid, NT = F.G * 512;
    for (int i = gt; i < (PH * 2 * 128 * 128) / 8; i += NT) cvt8(F.keys + (size_t)i * 8, F.KEYS + (size_t)i * 8);
    for (int i = gt; i < (4 * 128 * 128) / 8; i += NT) { const int s0 = (i & 15) * 8, tt = (i >> 4) & 127;
        const f32x4 a = *(const GAS f32x4*)(F.sp_w + (size_t)i * 8), b = *(const GAS f32x4*)(F.sp_w + (size_t)i * 8 + 4);
        float v[8] = {a.x, a.y, a.z, a.w, b.x, b.y, b.z, b.w};
#pragma unroll
        for (int j = 0; j < 8; ++j) v[j] = (s0 + j <= tt) ? v[j] : 0.f;
        v4u o; o.x = pk2(v[0], v[1]); o.y = pk2(v[2], v[3]); o.z = pk2(v[4], v[5]); o.w = pk2(v[6], v[7]);
        *(GAS v4u*)(F.SPW + (size_t)i * 8) = o; }
    for (int i = gt; i < HW; i += NT) { const float g0 = F.lb_gamma[i], g1 = F.lb_gamma[HW + i]; F.LB[i] = 1.f / (1.f + __expf(g1 - g0)); }
    {
        const int gw = F.vcu * NWAVES + F.wave, NGW = F.G * NWAVES;
        for (int r0 = gw; r0 < 2 * 16384; r0 += 2 * NGW) {
            f32x4 vv[2][4];
#pragma unroll
            for (int k = 0; k < 2; ++k) { const int r = r0 + k * NGW; const bool isv = r >= 16384; const int row = isv ? r - 16384 : r;
                const GAS f32x4* src = (const GAS f32x4*)((isv ? F.pv : F.pu) + (size_t)row * DM) + F.lane;
#pragma unroll
                for (int j = 0; j < 4; ++j) vv[k][j] = src[64 * j]; }
#pragma unroll
            for (int k = 0; k < 2; ++k) { const int r = r0 + k * NGW; const bool isv = r >= 16384; const int row = isv ? r - 16384 : r;
            unsigned char* part = F.UT + (size_t)row * P10_REC + (isv ? P10_UB : 0);
            f32x4 v[4];
#pragma unroll
            for (int j = 0; j < 4; ++j) v[j] = vv[k][j];
            if (isv ? (P10_V4 != 0) : (P10_U4 != 0)) {
                const int off = isv ? 8 : 0;
#pragma unroll
                for (int j = 0; j < 4; ++j) {
                    float mp = fmaxf(fmaxf(v[j].x, v[j].y), fmaxf(v[j].z, v[j].w)), mn = fmaxf(fmaxf(-v[j].x, -v[j].y), fmaxf(-v[j].z, -v[j].w));
                    mp = fmaxf(mp, __shfl_xor(mp, 1)); mp = fmaxf(mp, __shfl_xor(mp, 2)); mp = fmaxf(mp, __shfl_xor(mp, 4));
                    mn = fmaxf(mn, __shfl_xor(mn, 1)); mn = fmaxf(mn, __shfl_xor(mn, 2)); mn = fmaxf(mn, __shfl_xor(mn, 4));
                    const float ssgn = mp >= mn ? -mp * 0.125f : mn * 0.125f;
                    const unsigned ab = f2bf(fabsf(ssgn)); const unsigned sb = ab | (ssgn < 0.f ? 0x8000u : 0u); const float sc = __uint_as_float(sb << 16), inv = ab != 0u ? 1.f / sc : 0.f;
                    const float xs[4] = {v[j].x, v[j].y, v[j].z, v[j].w}; unsigned pk = 0u;
#pragma unroll
                    for (int e = 0; e < 4; ++e) { int q = (int)rintf(xs[e] * inv); q = q < -8 ? -8 : (q > 7 ? 7 : q); pk |= ((unsigned)(q + off) & 15u) << (4 * e); }
                    *(GAS unsigned short*)(part + 128 * j + 2 * F.lane) = (unsigned short)pk;
                    if ((F.lane & 7) == 0) { const int g = 8 * j + (F.lane >> 3); *(GAS unsigned short*)(F.UT + (size_t)row * P10_REC + 1024 + 8 * (g & 15) + (isv ? 4 : 0) + 2 * (g >> 4)) = (unsigned short)sb; } }
            } else {
                float mx = 0.f;
#pragma unroll
                for (int j = 0; j < 4; ++j) mx = fmaxf(mx, fmaxf(fmaxf(fabsf(v[j].x), fabsf(v[j].y)), fmaxf(fabsf(v[j].z), fabsf(v[j].w))));
#pragma unroll
                for (int o = 1; o < 64; o <<= 1) mx = fmaxf(mx, __shfl_xor(mx, o));
                const float inv = mx > 0.f ? 127.f / mx : 0.f; const int off = isv ? 128 : 0;
                GAS unsigned* dst = (GAS unsigned*)part + F.lane;
#pragma unroll
                for (int j = 0; j < 4; ++j) { const unsigned b0 = (unsigned)((int)rintf(v[j].x * inv) + off) & 0xffu, b1 = (unsigned)((int)rintf(v[j].y * inv) + off) & 0xffu, b2 = (unsigned)((int)rintf(v[j].z * inv) + off) & 0xffu, b3 = (unsigned)((int)rintf(v[j].w * inv) + off) & 0xffu;
                    dst[64 * j] = b0 | (b1 << 8) | (b2 << 16) | (b3 << 24); }
                if (F.lane == 0) (isv ? F.VSC : F.USC)[row] = mx * (1.f / 127.f); } } }
    }
}

__device__ __forceinline__ void norm_row_to_bf16(const float* xrow, bf16* orow, const f32x4 (&gs)[4], const f32x4 (&sh)[4], int lane) {
    const GAS f32x4* xr = (const GAS f32x4*)xrow + lane;
    f32x4 v[4]; float s2 = 0.f;
#pragma unroll
    for (int j = 0; j < 4; ++j) { v[j] = xr[64 * j]; s2 += (v[j].x * v[j].x + v[j].y * v[j].y) + (v[j].z * v[j].z + v[j].w * v[j].w); }
    const float rstd = rsq_f(wave_sum(s2) * (1.f / DM) + EPS);
    GAS v2u* o8 = (GAS v2u*)orow + lane;
#pragma unroll
    for (int j = 0; j < 4; ++j) { const f32x4 y = v[j] * rstd * gs[j] + sh[j]; v2u o; o.x = pk2(y.x, y.y); o.y = pk2(y.z, y.w); o8[64 * j] = o; }
}

__device__ __forceinline__ void norm_bf16row_to_bf16(const bf16* xrow, bf16* orow, const f32x4 (&gs)[4], const f32x4 (&sh)[4], int lane) {
    const GAS v2u* xr = (const GAS v2u*)xrow + lane;
    f32x4 v[4]; float s2 = 0.f;
#pragma unroll
    for (int j = 0; j < 4; ++j) { const v2u w = xr[64 * j]; v[j] = (f32x4){bflo(w.x), bfhi(w.x), bflo(w.y), bfhi(w.y)}; s2 += (v[j].x * v[j].x + v[j].y * v[j].y) + (v[j].z * v[j].z + v[j].w * v[j].w); }
    const float rstd = rsq_f(wave_sum(s2) * (1.f / DM) + EPS);
    GAS v2u* o8 = (GAS v2u*)orow + lane;
#pragma unroll
    for (int j = 0; j < 4; ++j) { const f32x4 y = v[j] * rstd * gs[j] + sh[j]; v2u o; o.x = pk2(y.x, y.y); o.y = pk2(y.z, y.w); o8[64 * j] = o; }
}

__device__ __forceinline__ void norm_rows4_f32(const float* x0, bf16* o0, const f32x4 (&gs)[4], const f32x4 (&sh)[4], int lane) {
    f32x4 v[4][4];
#pragma unroll
    for (int r = 0; r < 4; ++r)
#pragma unroll
        for (int j = 0; j < 4; ++j) v[r][j] = ((const GAS f32x4*)(x0 + (size_t)r * DM) + lane)[64 * j];
#pragma unroll
    for (int r = 0; r < 4; ++r) { float s2 = 0.f;
#pragma unroll
        for (int j = 0; j < 4; ++j) s2 += (v[r][j].x * v[r][j].x + v[r][j].y * v[r][j].y) + (v[r][j].z * v[r][j].z + v[r][j].w * v[r][j].w);
        const float rstd = rsq_f(wave_sum(s2) * (1.f / DM) + EPS); GAS v2u* o8 = (GAS v2u*)(o0 + (size_t)r * DM) + lane;
#pragma unroll
        for (int j = 0; j < 4; ++j) { const f32x4 y = v[r][j] * rstd * gs[j] + sh[j]; v2u o; o.x = pk2(y.x, y.y); o.y = pk2(y.z, y.w); o8[64 * j] = o; } }
}
__device__ __forceinline__ void norm_rows4_bf16(const bf16* x0, bf16* o0, const f32x4 (&gs)[4], const f32x4 (&sh)[4], int lane) {
    v2u w[4][4];
#pragma unroll
    for (int r = 0; r < 4; ++r)
#pragma unroll
        for (int j = 0; j < 4; ++j) w[r][j] = ((const GAS v2u*)(x0 + (size_t)r * DM) + lane)[64 * j];
#pragma unroll
    for (int r = 0; r < 4; ++r) { f32x4 v[4]; float s2 = 0.f;
#pragma unroll
        for (int j = 0; j < 4; ++j) { v[j] = (f32x4){bflo(w[r][j].x), bfhi(w[r][j].x), bflo(w[r][j].y), bfhi(w[r][j].y)}; s2 += (v[j].x * v[j].x + v[j].y * v[j].y) + (v[j].z * v[j].z + v[j].w * v[j].w); }
        const float rstd = rsq_f(wave_sum(s2) * (1.f / DM) + EPS); GAS v2u* o8 = (GAS v2u*)(o0 + (size_t)r * DM) + lane;
#pragma unroll
        for (int j = 0; j < 4; ++j) { const f32x4 y = v[j] * rstd * gs[j] + sh[j]; v2u o; o.x = pk2(y.x, y.y); o.y = pk2(y.z, y.w); o8[64 * j] = o; } }
}

__device__ __forceinline__ void norm_store_i8(const f32x4 (&v)[4], float rstd, const f32x4 (&gs)[4], const f32x4 (&sh)[4], unsigned char* orow, float* sa, int lane) {
    f32x4 y[4]; float mx = 0.f;
#pragma unroll
    for (int j = 0; j < 4; ++j) { y[j] = v[j] * rstd * gs[j] + sh[j]; mx = fmaxf(mx, fmaxf(fmaxf(fabsf(y[j].x), fabsf(y[j].y)), fmaxf(fabsf(y[j].z), fabsf(y[j].w)))); }
#pragma unroll
    for (int o = 1; o < 64; o <<= 1) mx = fmaxf(mx, __shfl_xor(mx, o));
    const float inv = mx > 0.f ? 119.f / mx : 0.f; GAS unsigned* o4 = (GAS unsigned*)orow + lane;
#pragma unroll
    for (int j = 0; j < 4; ++j) o4[64 * j] = ((unsigned)(int)rintf(y[j].x * inv) & 0xffu) | (((unsigned)(int)rintf(y[j].y * inv) & 0xffu) << 8) | (((unsigned)(int)rintf(y[j].z * inv) & 0xffu) << 16) | (((unsigned)(int)rintf(y[j].w * inv) & 0xffu) << 24);
    if (lane == 0) *sa = mx * (1.f / 119.f);
}
__device__ __forceinline__ void norm_rows4_f32_i8(const float* x0, unsigned char* o0, float* sa0, const f32x4 (&gs)[4], const f32x4 (&sh)[4], int lane) {
    f32x4 v[4][4];
#pragma unroll
    for (int r = 0; r < 4; ++r)
#pragma unroll
        for (int j = 0; j < 4; ++j) v[r][j] = ((const GAS f32x4*)(x0 + (size_t)r * DM) + lane)[64 * j];
#pragma unroll
    for (int r = 0; r < 4; ++r) { float s2 = 0.f;
#pragma unroll
        for (int j = 0; j < 4; ++j) s2 += (v[r][j].x * v[r][j].x + v[r][j].y * v[r][j].y) + (v[r][j].z * v[r][j].z + v[r][j].w * v[r][j].w);
        norm_store_i8(v[r], rsq_f(wave_sum(s2) * (1.f / DM) + EPS), gs, sh, o0 + (size_t)r * DM, sa0 + r, lane); }
}
__device__ __forceinline__ void norm_rows4_bf16_i8(const bf16* x0, unsigned char* o0, float* sa0, const f32x4 (&gs)[4], const f32x4 (&sh)[4], int lane) {
    v2u w[4][4];
#pragma unroll
    for (int r = 0; r < 4; ++r)
#pragma unroll
        for (int j = 0; j < 4; ++j) w[r][j] = ((const GAS v2u*)(x0 + (size_t)r * DM) + lane)[64 * j];
#pragma unroll
    for (int r = 0; r < 4; ++r) { f32x4 v[4]; float s2 = 0.f;
#pragma unroll
        for (int j = 0; j < 4; ++j) { v[j] = (f32x4){bflo(w[r][j].x), bfhi(w[r][j].x), bflo(w[r][j].y), bfhi(w[r][j].y)}; s2 += (v[j].x * v[j].x + v[j].y * v[j].y) + (v[j].z * v[j].z + v[j].w * v[j].w); }
        norm_store_i8(v, rsq_f(wave_sum(s2) * (1.f / DM) + EPS), gs, sh, o0 + (size_t)r * DM, sa0 + r, lane); }
}

__device__ __forceinline__ void p1_norm1(Frame& F) {
    LAS float* modl = (LAS float*)(F.lds);
    const int b = F.vcu >> 6;
    {
        float sv[6];
#pragma unroll
        for (int j = 0; j < 6; ++j) { const int n = ((j >> 1) == 2 ? 4096 : (j >> 1) * 1024) + (j & 1) * 512 + F.tid; float s = F.ada_b[n];
#pragma unroll
            for (int kg = 0; kg < 8; ++kg) s += F.MODP[(size_t)(kg * 4 + b) * 6144 + n];
            sv[j] = s; }
#pragma unroll
        for (int j = 0; j < 6; ++j) { const int n = ((j >> 1) == 2 ? 4096 : (j >> 1) * 1024) + (j & 1) * 512 + F.tid; modl[n] = sv[j]; if ((F.vcu & 63) == 0) F.MOD[(size_t)b * 6144 + n] = sv[j]; }
        if ((F.vcu & 63) == 0) {
#pragma unroll
            for (int j = 0; j < 6; ++j) { const int n = ((j >> 1) == 2 ? 5120 : 2048 + (j >> 1) * 1024) + (j & 1) * 512 + F.tid; float s = F.ada_b[n];
#pragma unroll
                for (int kg = 0; kg < 8; ++kg) s += F.MODP[(size_t)(kg * 4 + b) * 6144 + n];
                F.MOD[(size_t)b * 6144 + n] = s; } }
    }
    __syncthreads();
    LAS float* gml = (LAS float*)(F.lds + LDS_SPARE);
    for (int n = F.tid; n < 1024; n += 512) { const float gv = F.norm2_g[n] * (1.f + modl[4096 + n]); gml[n] = gv; if ((F.vcu & 63) == 0) F.GM[(size_t)b * 1024 + n] = gv; }
    f32x4 gs[4], sh[4];
#pragma unroll
    for (int j = 0; j < 4; ++j) { const int c0 = 256 * j + 4 * F.lane; const f32x4 g = *(const GAS f32x4*)(F.norm1_g + c0);
        const f32x4 sc = *(LAS f32x4*)(modl + 1024 + c0); sh[j] = *(LAS f32x4*)(modl + c0); gs[j] = g * (sc + 1.f); }
    const int r0 = F.vcu * 128 + F.wave * 16;
    for (int i = 0; i < 16; i += 4) { if (G1_I8) norm_rows4_f32_i8(F.x + (size_t)(r0 + i) * DM, (unsigned char*)F.XN + (size_t)(r0 + i) * DM, F.SA + r0 + i, gs, sh, F.lane);
        else norm_rows4_f32(F.x + (size_t)(r0 + i) * DM, F.XN + (size_t)(r0 + i) * DM, gs, sh, F.lane); }
    __syncthreads();
    {
        LAS float* scr = (LAS float*)(F.lds + F.wave * 16384);
        const int gw = F.vcu * NWAVES + F.wave, NGW = F.G * NWAVES;
        constexpr int I_IN = (DM / 64) * (NPROJ / 32), I_Q = (DM / 64) * (NQ / 32);
        for (int it = gw; it < I_IN; it += NGW) { if (G1_I8) p1_qtranspose_item(F.w_in, DM, NPROJ, (unsigned char*)F.WIN, (const unsigned*)(F.ctl + CW_COLMAX), F.SW, scr, it, F.lane); else p0_transpose_item(F.w_in, DM, NPROJ, F.WIN, 0, scr, it, F.lane); }
        for (int it = (F.vcu & 63) * NWAVES + F.wave; it < I_Q; it += 64 * NWAVES) p1_fold_item(F.wq, DM, NQ, F.WQF + (size_t)b * NQ * DM, gml, scr, it, F.lane);
    }
    __syncthreads();
}
__device__ __forceinline__ void p7_norm2(Frame& F) {
    const int b = F.vcu >> 6; const float* mod = F.MOD + (size_t)b * 6144;
    f32x4 gs[4], sh[4];
#pragma unroll
    for (int j = 0; j < 4; ++j) { const int c0 = 256 * j + 4 * F.lane; const f32x4 g = *(const GAS f32x4*)(F.norm2_g + c0);
        const f32x4 sc = *(const GAS f32x4*)(mod + 4096 + c0); sh[j] = *(const GAS f32x4*)(mod + 3072 + c0); gs[j] = g * (sc + 1.f); }
    const int r0 = F.vcu * 128 + F.wave * 16;
    for (int i = 0; i < 16; i += 4) { if (G3_I8) norm_rows4_bf16_i8(F.X1 + (size_t)(r0 + i) * DM, (unsigned char*)F.XN + (size_t)(r0 + i) * DM, F.SA + r0 + i, gs, sh, F.lane);
        else norm_rows4_bf16(F.X1 + (size_t)(r0 + i) * DM, F.XN + (size_t)(r0 + i) * DM, gs, sh, F.lane); }
}

#define MFMA16(a, b, c) __builtin_amdgcn_mfma_f32_16x16x32_bf16((a), (b), (c), 0, 0, 0)
#define MFMA32(a, b, c) __builtin_amdgcn_mfma_f32_32x32x16_bf16((a), (b), (c), 0, 0, 0)

struct HRawA { unsigned short z[16], v[16]; };
__device__ __forceinline__ void hgrnA_load(Frame& F, int u, HRawA& r) {
    const int bh = u >> 7, c = u & 127, b = bh >> 2, h = bh & 3, t0 = b * SEQ + c * HCH;
    const int col = F.tid & 127, rg = F.tid >> 7;
    const bf16* pz = F.PROJ + (size_t)(t0 + rg * 16) * NPROJ + HW + h * HD + col;
    const bf16* pv = pz + HW;
#pragma unroll
    for (int i = 0; i < 16; ++i) { r.z[i] = pz[(size_t)i * NPROJ]; r.v[i] = pv[(size_t)i * NPROJ]; }
}
__device__ __forceinline__ void hgrnA_unit(Frame& F, int u, const HRawA& r) {
    const int bh = u >> 7, c = u & 127, b = bh >> 2, h = bh & 3, t0 = b * SEQ + c * HCH; (void)t0; (void)c; (void)b;
    const int col = F.tid & 127, rg = F.tid >> 7;
    LAS unsigned short* KT = (LAS unsigned short*)(F.lds);
    LAS unsigned short* VT = (LAS unsigned short*)(F.lds + 18432);
    LAS float* TOT = (LAS float*)(F.lds + 36864);
    const float lbv = F.LB[h * HD + col], oml = 1.f - lbv;
    float lg[16], kk[16]; unsigned vv[16]; float run = 0.f;
#pragma unroll
    for (int i = 0; i < 16; ++i) { const float z = bf2f(r.z[i]); const float e = __expf(-z), s = rcp_f(1.f + e);
        run += __logf(lbv + oml * s); lg[i] = run; kk[i] = oml * e * s; vv[i] = r.v[i]; }
    TOT[rg * 128 + col] = run;
    __syncthreads();
    float pre = 0.f, tot = 0.f;
#pragma unroll
    for (int g = 0; g < 4; ++g) { const float tv = TOT[g * 128 + col]; pre += (g < rg) ? tv : 0.f; tot += tv; }
    unsigned kw[8], vw[8];
#pragma unroll
    for (int i = 0; i < 8; ++i) { kw[i] = pk2(kk[2 * i] * __expf(-(pre + lg[2 * i])), kk[2 * i + 1] * __expf(-(pre + lg[2 * i + 1]))); vw[i] = vv[2 * i] | (vv[2 * i + 1] << 16); }
    *(LAS v4u*)(KT + col * 72 + rg * 16) = (v4u){kw[0], kw[1], kw[2], kw[3]}; *(LAS v4u*)(KT + col * 72 + rg * 16 + 8) = (v4u){kw[4], kw[5], kw[6], kw[7]};
    *(LAS v4u*)(VT + col * 72 + rg * 16) = (v4u){vw[0], vw[1], vw[2], vw[3]}; *(LAS v4u*)(VT + col * 72 + rg * 16 + 8) = (v4u){vw[4], vw[5], vw[6], vw[7]};
    if (rg == 0) F.DEC[(size_t)u * 128 + col] = __expf(tot);
    __syncthreads();
    const int fr = F.lane & 15, fq = F.lane >> 4, w = F.wave;
    bf16x8 a[2];
#pragma unroll
    for (int ks = 0; ks < 2; ++ks) a[ks] = *(LAS bf16x8*)(KT + (16 * w + fr) * 72 + ks * 32 + fq * 8);
    bf16* st = F.STATE + (size_t)u * 16384;
#pragma unroll
    for (int n = 0; n < 8; ++n) { f32x4 acc = (f32x4){0.f, 0.f, 0.f, 0.f};
#pragma unroll
        for (int ks = 0; ks < 2; ++ks) { const bf16x8 bb = *(LAS bf16x8*)(VT + (16 * n + fr) * 72 + ks * 32 + fq * 8); acc = MFMA16(a[ks], bb, acc); }
        v2u o; o.x = pk2_sw(acc[0], acc[1]); o.y = pk2_sw(acc[2], acc[3]);
        *(GAS v2u*)(st + (16 * n + fr) * 128 + 16 * w + 4 * fq) = o; }
    __syncthreads();
}

__device__ __forceinline__ void gmlp_unit(Frame& F, int u) {
    const int b = u >> 6, n = u & 63, t0 = b * SEQ + n * 128, t = F.tid >> 2, q = F.tid & 3;
    LAS unsigned short* VnT = (LAS unsigned short*)(F.lds);
    LAS float* Og = (LAS float*)(F.lds + 34816);
    const bf16* prow = F.PROJ + (size_t)(t0 + t) * NPROJ;
    float sum = 0.f, sq = 0.f;
#pragma unroll
    for (int g = 0; g < 4; ++g)
#pragma unroll
        for (int k = 0; k < 4; ++k) { const v4u w = *(const GAS v4u*)(prow + 2560 + g * 128 + (4 * k + q) * 8);
            const unsigned ww[4] = {w.x, w.y, w.z, w.w};
#pragma unroll
            for (int j = 0; j < 4; ++j) { const float lo = gelu_f(bflo(ww[j])), hi = gelu_f(bfhi(ww[j])); sum += lo + hi; sq += lo * lo + hi * hi; } }
    sum += __shfl_xor(sum, 1); sum += __shfl_xor(sum, 2); sq += __shfl_xor(sq, 1); sq += __shfl_xor(sq, 2);
    const float mean = sum * (1.f / 512.f); const float var = fmaxf(sq * (1.f / 512.f) - mean * mean, 0.f);
    const float rstd = rsq_f(var + EPS);
    const int fr = F.lane & 15, fq = F.lane >> 4, w = F.wave;
    for (int g = 0; g < 4; ++g) {
#pragma unroll
        for (int k = 0; k < 4; ++k) { const int lc = (4 * k + q) * 8, ch = g * 128 + lc;
            const v4u wv = *(const GAS v4u*)(prow + 2560 + ch); const unsigned ww[4] = {wv.x, wv.y, wv.z, wv.w};
            const f32x4 lga = *(const GAS f32x4*)(F.ln_g + ch), lgb = *(const GAS f32x4*)(F.ln_g + ch + 4), lba = *(const GAS f32x4*)(F.ln_b + ch), lbb = *(const GAS f32x4*)(F.ln_b + ch + 4);
            const float lgs[8] = {lga.x, lga.y, lga.z, lga.w, lgb.x, lgb.y, lgb.z, lgb.w}, lbs[8] = {lba.x, lba.y, lba.z, lba.w, lbb.x, lbb.y, lbb.z, lbb.w};
#pragma unroll
            for (int j = 0; j < 4; ++j) { const float lo = gelu_f(bflo(ww[j])), hi = gelu_f(bfhi(ww[j]));
                VnT[(lc + 2 * j) * 136 + t] = (unsigned short)f2bf((lo - mean) * rstd * lgs[2 * j] + lbs[2 * j]);
                VnT[(lc + 2 * j + 1) * 136 + t] = (unsigned short)f2bf((hi - mean) * rstd * lgs[2 * j + 1] + lbs[2 * j + 1]); } }
        v4u uw[4];
#pragma unroll
        for (int k = 0; k < 4; ++k) uw[k] = *(const GAS v4u*)(prow + 2048 + g * 128 + (4 * k + q) * 8);
        __syncthreads();
        bf16x8 a[4];
#pragma unroll
        for (int ks = 0; ks < 4; ++ks) a[ks] = *(const GAS bf16x8*)(F.SPW + (size_t)(g * 128 + 16 * w + fr) * 128 + ks * 32 + fq * 8);
        f32x4 sb;
#pragma unroll
        for (int r = 0; r < 4; ++r) sb[r] = F.sp_b[g * 128 + 16 * w + 4 * fq + r];
#pragma unroll
        for (int nn = 0; nn < 8; ++nn) { f32x4 acc = (f32x4){0.f, 0.f, 0.f, 0.f};
#pragma unroll
            for (int ks = 0; ks < 4; ++ks) { const bf16x8 bb = *(LAS bf16x8*)(VnT + (16 * nn + fr) * 136 + ks * 32 + fq * 8); acc = MFMA16(a[ks], bb, acc); }
#pragma unroll
            for (int r = 0; r < 4; ++r) Og[(16 * w + 4 * fq + r) * 132 + 16 * nn + fr] = acc[r] + sb[r]; }
        __syncthreads();
        float gm[32]; float ss = 0.f;
#pragma unroll
        for (int k = 0; k < 4; ++k) { const int lc = (4 * k + q) * 8; const unsigned ww[4] = {uw[k].x, uw[k].y, uw[k].z, uw[k].w};
            const f32x4 ma = *(LAS f32x4*)(Og + t * 132 + lc), mb = *(LAS f32x4*)(Og + t * 132 + lc + 4); const float ms[8] = {ma.x, ma.y, ma.z, ma.w, mb.x, mb.y, mb.z, mb.w};
#pragma unroll
            for (int j = 0; j < 4; ++j) { const float g0 = gelu_f(bflo(ww[j])) * ms[2 * j], g1 = gelu_f(bfhi(ww[j])) * ms[2 * j + 1]; gm[k * 8 + 2 * j] = g0; gm[k * 8 + 2 * j + 1] = g1; ss += g0 * g0 + g1 * g1; } }
        ss += __shfl_xor(ss, 1); ss += __shfl_xor(ss, 2);
        const float rs = rsq_f(ss * (1.f / 128.f) + EPS);
#pragma unroll
        for (int k = 0; k < 4; ++k) { const int lc = (4 * k + q) * 8; v4u o; const f32x4 ga = *(const GAS f32x4*)(F.gm_g + g * 128 + lc), gb = *(const GAS f32x4*)(F.gm_g + g * 128 + lc + 4);
            o.x = pk2(gm[k * 8 + 0] * rs * ga.x, gm[k * 8 + 1] * rs * ga.y); o.y = pk2(gm[k * 8 + 2] * rs * ga.z, gm[k * 8 + 3] * rs * ga.w);
            o.z = pk2(gm[k * 8 + 4] * rs * gb.x, gm[k * 8 + 5] * rs * gb.y); o.w = pk2(gm[k * 8 + 6] * rs * gb.z, gm[k * 8 + 7] * rs * gb.w);
            *(GAS v4u*)(F.CAT + (size_t)(t0 + t) * DM + 512 + g * 128 + lc) = o; }
    }
    __syncthreads();
}

__device__ __forceinline__ void p4_qbias(Frame& F) {
    LAS float* red = (LAS float*)(F.lds + LDS_SPARE);
    const int ks = F.tid >> 3, c = F.tid & 7, n = F.vcu * 8 + c; float a[4] = {0.f, 0.f, 0.f, 0.f};
#pragma unroll
    for (int kk = 0; kk < 16; ++kk) { const int k = ks * 16 + kk; const float w = F.wq[(size_t)k * NQ + n];
#pragma unroll
        for (int b = 0; b < 4; ++b) a[b] += F.MOD[(size_t)b * 6144 + 3072 + k] * w; }
#pragma unroll
    for (int b = 0; b < 4; ++b) red[ks * 32 + b * 8 + c] = a[b];
    __syncthreads();
    if (F.tid < 32) { float s = 0.f;
        for (int j = 0; j < 64; ++j) s += red[j * 32 + F.tid];
        F.QBIAS[(size_t)(F.tid >> 3) * NQ + F.vcu * 8 + (F.tid & 7)] = s; }
}
__device__ __forceinline__ void p4_scan(Frame& F) {
    const int bh = F.vcu >> 4, e = ((F.vcu & 15) * 512 + F.tid) * 2, dk = e & 127;
    const bf16* st = F.STATE + (size_t)bh * 128 * 16384 + e; bf16* so = F.XN + (size_t)bh * 128 * 16384 + e; const float* dc = F.DEC + (size_t)bh * 128 * 128 + dk;
    float s0 = 0.f, s1 = 0.f;
    for (int c0 = 0; c0 < 128; c0 += 32) {
        unsigned l[32]; float d0[32], d1[32];
#pragma unroll
        for (int i = 0; i < 32; ++i) { l[i] = *(const GAS unsigned*)(st + (size_t)(c0 + i) * 16384); const f32x2 dd = *(const GAS f32x2*)(dc + (size_t)(c0 + i) * 128); d0[i] = dd.x; d1[i] = dd.y; }
#pragma unroll
        for (int i = 0; i < 32; ++i) { *(GAS unsigned*)(so + (size_t)(c0 + i) * 16384) = pk2(s0, s1); s0 = d0[i] * (s0 + bflo(l[i])); s1 = d1[i] * (s1 + bfhi(l[i])); }
    }
}

struct HRawC { unsigned z[16], v[16], q[16]; };
__device__ __forceinline__ void hgrnC_load(Frame& F, int u, HRawC& R) {
    const int bh = u >> 7, c = u & 127, b = bh >> 2, h = bh & 3, t0 = b * SEQ + c * HCH, col = F.tid & 127, rg = F.tid >> 7;
    const bf16* pq = F.PROJ + (size_t)(t0 + rg * 16) * NPROJ + h * HD + col;
#pragma unroll
    for (int i = 0; i < 16; ++i) { R.z[i] = pq[(size_t)i * NPROJ + HW]; R.v[i] = pq[(size_t)i * NPROJ + 2 * HW]; R.q[i] = pq[(size_t)i * NPROJ]; }
}
__device__ __forceinline__ void hgrnC_unit(Frame& F, int u, const HRawC& R) {
    const int bh = u >> 7, c = u & 127, b = bh >> 2, h = bh & 3, t0 = b * SEQ + c * HCH;
    const int col = F.tid & 127, rg = F.tid >> 7;
    LAS unsigned short* Qs = (LAS unsigned short*)(F.lds);
    LAS unsigned short* Ks = (LAS unsigned short*)(F.lds + 17408);
    LAS unsigned short* VT = (LAS unsigned short*)(F.lds + 34816);
    LAS unsigned short* Ps = (LAS unsigned short*)(F.lds + 53248);
    LAS float* TOT = (LAS float*)(F.lds + 62464);
    LAS float* Os = (LAS float*)(F.lds + 64512);
    const float lbv = F.LB[h * HD + col], oml = 1.f - lbv;
    float lg[16], kk[16], qq[16]; unsigned vv[16]; float run = 0.f;
#pragma unroll
    for (int i = 0; i < 16; ++i) { const float z = bf2f((unsigned short)R.z[i]); const float e = __expf(-z), s = rcp_f(1.f + e);
        run += __logf(lbv + oml * s); lg[i] = run; kk[i] = oml * e * s; vv[i] = R.v[i]; qq[i] = silu_f(bf2f((unsigned short)R.q[i])); }
    TOT[rg * 128 + col] = run;
    __syncthreads();
    float pre = 0.f;
#pragma unroll
    for (int g = 0; g < 4; ++g) { const float tv = TOT[g * 128 + col]; pre += (g < rg) ? tv : 0.f; }
    unsigned vw[8];
#pragma unroll
    for (int i = 0; i < 16; ++i) { const float bb = pre + lg[i]; Qs[(rg * 16 + i) * 136 + col] = (unsigned short)f2bf(qq[i] * __expf(bb)); Ks[(rg * 16 + i) * 136 + col] = (unsigned short)f2bf(kk[i] * __expf(-bb)); }
#pragma unroll
    for (int i = 0; i < 8; ++i) vw[i] = vv[2 * i] | (vv[2 * i + 1] << 16);
    *(LAS v4u*)(VT + col * 72 + rg * 16) = (v4u){vw[0], vw[1], vw[2], vw[3]}; *(LAS v4u*)(VT + col * 72 + rg * 16 + 8) = (v4u){vw[4], vw[5], vw[6], vw[7]};
    __syncthreads();
    const int fr = F.lane & 15, fq = F.lane >> 4, w = F.wave;
    {
        const int tt = w >> 1;
#pragma unroll
        for (int j = 0; j < 2; ++j) { const int st = (w & 1) * 2 + j; f32x4 acc = (f32x4){0.f, 0.f, 0.f, 0.f};
            if (st <= tt) {
#pragma unroll
                for (int ks = 0; ks < 4; ++ks) { const bf16x8 aa = *(LAS bf16x8*)(Qs + (16 * tt + fr) * 136 + ks * 32 + fq * 8); const bf16x8 bb = *(LAS bf16x8*)(Ks + (16 * st + fr) * 136 + ks * 32 + fq * 8); acc = MFMA16(aa, bb, acc); } }
#pragma unroll
            for (int r = 0; r < 4; ++r) { const int tr = 16 * tt + 4 * fq + r, sc = 16 * st + fr; Ps[tr * 72 + sc] = (unsigned short)f2bf_sw(sc <= tr ? acc[r] : 0.f); } }
    }
    __syncthreads();
    {
        bf16x8 bi[2], bs[4]; const bf16* st = F.XN + (size_t)u * 16384 + (size_t)(16 * w + fr) * 128 + fq * 8;
#pragma unroll
        for (int ks = 0; ks < 2; ++ks) bi[ks] = *(LAS bf16x8*)(VT + (16 * w + fr) * 72 + ks * 32 + fq * 8);
#pragma unroll
        for (int ks = 0; ks < 4; ++ks) bs[ks] = *(const GAS bf16x8*)(st + ks * 32);
#pragma unroll
        for (int tt = 0; tt < 4; ++tt) { f32x4 acc = (f32x4){0.f, 0.f, 0.f, 0.f};
#pragma unroll
            for (int ks = 0; ks < 2; ++ks) { const bf16x8 aa = *(LAS bf16x8*)(Ps + (16 * tt + fr) * 72 + ks * 32 + fq * 8); acc = MFMA16(aa, bi[ks], acc); }
#pragma unroll
            for (int ks = 0; ks < 4; ++ks) { const bf16x8 aa = *(LAS bf16x8*)(Qs + (16 * tt + fr) * 136 + ks * 32 + fq * 8); acc = MFMA16(aa, bs[ks], acc); }
#pragma unroll
            for (int r = 0; r < 4; ++r) Os[(16 * tt + 4 * fq + r) * 132 + 16 * w + fr] = acc[r]; }
    }
    __syncthreads();
    {
        const int row = F.tid >> 3, cs = (F.tid & 7) * 16; float o[16]; float ss = 0.f;
#pragma unroll
        for (int k = 0; k < 4; ++k) { const f32x4 v = *(LAS f32x4*)(Os + row * 132 + cs + 4 * k); o[4 * k] = v.x; o[4 * k + 1] = v.y; o[4 * k + 2] = v.z; o[4 * k + 3] = v.w; ss += (v.x * v.x + v.y * v.y) + (v.z * v.z + v.w * v.w); }
        ss += __shfl_xor(ss, 1); ss += __shfl_xor(ss, 2); ss += __shfl_xor(ss, 4);
        const float rs = rsq_f(ss * (1.f / 128.f) + EPS);
        const bf16* pog = F.PROJ + (size_t)(t0 + row) * NPROJ + 3 * HW + h * HD + cs; const float* gg = F.hgrn_g + h * HD + cs;
        bf16* orow = F.CAT + (size_t)(t0 + row) * DM + h * HD + cs;
#pragma unroll
        for (int k = 0; k < 2; ++k) { const v4u gw = *(const GAS v4u*)(pog + 8 * k); const unsigned ww[4] = {gw.x, gw.y, gw.z, gw.w}; unsigned ow[4];
#pragma unroll
            for (int j = 0; j < 4; ++j) { const int i0 = 8 * k + 2 * j; ow[j] = pk2(o[i0] * rs * gg[i0] * silu_f(bflo(ww[j])), o[i0 + 1] * rs * gg[i0 + 1] * silu_f(bfhi(ww[j]))); }
            *(GAS v4u*)(orow + 8 * k) = (v4u){ow[0], ow[1], ow[2], ow[3]}; }
    }
    __syncthreads();
}

__device__ __forceinline__ unsigned f2sort(float f) { const unsigned u = __float_as_uint(f); return (u & 0x80000000u) ? ~u : (u | 0x80000000u); }
__device__ __forceinline__ float sort2f(unsigned s) { const unsigned u = (s & 0x80000000u) ? (s & 0x7fffffffu) : ~s; return __uint_as_float(u); }
__device__ __forceinline__ void insert16(unsigned (&L)[16], unsigned x) {
#pragma unroll
    for (int i = 0; i < 16; ++i) { const unsigned hi = L[i] > x ? L[i] : x; x = L[i] > x ? x : L[i]; L[i] = hi; }
}
__device__ __forceinline__ void ce_desc(unsigned& a, unsigned& b) { const unsigned mx = a > b ? a : b, mn = a > b ? b : a; a = mx; b = mn; }
__device__ __forceinline__ void sort16_desc(unsigned (&x)[16]) {
    ce_desc(x[0], x[13]); ce_desc(x[1], x[12]); ce_desc(x[2], x[15]); ce_desc(x[3], x[14]); ce_desc(x[4], x[8]); ce_desc(x[5], x[6]); ce_desc(x[7], x[11]); ce_desc(x[9], x[10]);
    ce_desc(x[0], x[5]); ce_desc(x[1], x[7]); ce_desc(x[2], x[9]); ce_desc(x[3], x[4]); ce_desc(x[6], x[13]); ce_desc(x[8], x[14]); ce_desc(x[10], x[15]); ce_desc(x[11], x[12]);
    ce_desc(x[0], x[1]); ce_desc(x[2], x[3]); ce_desc(x[4], x[5]); ce_desc(x[6], x[8]); ce_desc(x[7], x[9]); ce_desc(x[10], x[11]); ce_desc(x[12], x[13]); ce_desc(x[14], x[15]);
    ce_desc(x[0], x[2]); ce_desc(x[1], x[3]); ce_desc(x[4], x[10]); ce_desc(x[5], x[11]); ce_desc(x[6], x[7]); ce_desc(x[8], x[9]); ce_desc(x[12], x[14]); ce_desc(x[13], x[15]);
    ce_desc(x[1], x[2]); ce_desc(x[3], x[12]); ce_desc(x[4], x[6]); ce_desc(x[5], x[7]); ce_desc(x[8], x[10]); ce_desc(x[9], x[11]); ce_desc(x[13], x[14]);
    ce_desc(x[1], x[4]); ce_desc(x[2], x[6]); ce_desc(x[5], x[8]); ce_desc(x[7], x[10]); ce_desc(x[9], x[13]); ce_desc(x[11], x[14]);
    ce_desc(x[2], x[4]); ce_desc(x[3], x[6]); ce_desc(x[9], x[12]); ce_desc(x[11], x[13]);
    ce_desc(x[3], x[5]); ce_desc(x[6], x[8]); ce_desc(x[7], x[9]); ce_desc(x[10], x[12]);
    ce_desc(x[3], x[4]); ce_desc(x[5], x[6]); ce_desc(x[7], x[8]); ce_desc(x[9], x[10]); ce_desc(x[11], x[12]);
    ce_desc(x[6], x[7]); ce_desc(x[8], x[9]);
}
__device__ __forceinline__ void merge16_desc(unsigned (&x)[16]) {
#pragma unroll
    for (int j = 8; j > 0; j >>= 1)
#pragma unroll
        for (int i = 0; i < 16; ++i) { const int l = i ^ j; if (l > i) ce_desc(x[i], x[l]); }
}
__device__ __forceinline__ void top16_merge(unsigned (&L)[16], const unsigned (&Tt)[16]) {
#pragma unroll
    for (int i = 0; i < 16; ++i) L[i] = L[i] > Tt[15 - i] ? L[i] : Tt[15 - i];
    merge16_desc(L);
}
struct QRaw { bf16x8 a[8], b[8]; };
__device__ __forceinline__ void route_load(Frame& F, int tg, int h, QRaw& q) {
    const int lane = F.lane, tok = tg * 32 + (lane & 31), hh = lane >> 5;
    const bf16* qrow = F.QB + (size_t)tok * NQ + h * 256 + 8 * hh;
#pragma unroll
    for (int ks = 0; ks < 8; ++ks) q.a[ks] = *(const GAS bf16x8*)(qrow + ks * 16);
#pragma unroll
    for (int ks = 0; ks < 8; ++ks) q.b[ks] = *(const GAS bf16x8*)(qrow + 128 + ks * 16);
}
__device__ __forceinline__ void route_job(Frame& F, int tg, int h, const QRaw& q) {
    const int lane = F.lane, tok = tg * 32 + (lane & 31), hh = lane >> 5;
    unsigned L1[16], L2[16];
#pragma unroll
    for (int i = 0; i < 16; ++i) { L1[i] = 0u; L2[i] = 0u; }
    bf16x8 bq[8], bqn[8];
#pragma unroll
    for (int ks = 0; ks < 8; ++ks) { bq[ks] = q.a[ks]; bqn[ks] = q.b[ks]; }
#pragma unroll 1
    for (int p = 0; p < 2; ++p) {
        const LAS unsigned short* krow = (const LAS unsigned short*)F.lds + (size_t)(p * 128 + (lane & 31)) * 136 + 8 * hh;
        unsigned L[16];
#pragma unroll
        for (int i = 0; i < 16; ++i) L[i] = 0u;
#pragma unroll 1
        for (int mt = 0; mt < 4; ++mt) { f32x16 acc;
#pragma unroll
            for (int r = 0; r < 16; ++r) acc[r] = 0.f;
#pragma unroll
            for (int ks = 0; ks < 8; ++ks) { const bf16x8 ak = *(const LAS bf16x8*)(krow + mt * 32 * 136 + ks * 16); acc = MFMA32(ak, bq[ks], acc); }
            unsigned Tt[16];
#pragma unroll
            for (int r = 0; r < 16; ++r) { const int n = 32 * mt + (r & 3) + 8 * (r >> 2) + 4 * hh; Tt[r] = (f2sort(acc[r]) & ~0x7Fu) | (unsigned)(127 - n); }
            sort16_desc(Tt); top16_merge(L, Tt); }
        unsigned Pp[16];
#pragma unroll
        for (int i = 0; i < 16; ++i) Pp[i] = (unsigned)__shfl_xor((int)L[i], 32);
        top16_merge(L, Pp);
#pragma unroll
        for (int i = 0; i < 16; ++i) { L1[i] = (p == 0) ? L[i] : L1[i]; L2[i] = (p == 0) ? L2[i] : L[i]; }
#pragma unroll
        for (int ks = 0; ks < 8; ++ks) bq[ks] = bqn[ks];
    }
    float v1[16], v2[16];
#pragma unroll
    for (int i = 0; i < 16; ++i) { v1[i] = sort2f(L1[i] & ~0x7Fu); v2[i] = sort2f(L2[i] & ~0x7Fu); }
    LAS unsigned char* tbl = (LAS unsigned char*)(F.lds + 69632 + F.wave * 2048) + lane;
#pragma unroll
    for (int i = 0; i < 16; ++i) { tbl[i * 64] = (unsigned char)(127u - (L1[i] & 0x7Fu)); tbl[(16 + i) * 64] = (unsigned char)(127u - (L2[i] & 0x7Fu)); }
#define CKEY(i, j) ((f2sort(v1[i] + v2[j]) & ~0xFFu) | (unsigned)(255 - ((i) * 16 + (j))))
    unsigned C[16], G[16];
#pragma unroll
    for (int j = 0; j < 16; ++j) C[j] = CKEY(0, j);
#pragma unroll
    for (int j = 0; j < 8; ++j) G[j] = CKEY(1, j);
#pragma unroll
    for (int j = 0; j < 5; ++j) G[8 + j] = CKEY(2, j);
#pragma unroll
    for (int j = 0; j < 3; ++j) G[13 + j] = CKEY(4, j);
    sort16_desc(G); top16_merge(C, G);
#pragma unroll
    for (int j = 0; j < 4; ++j) G[j] = CKEY(3, j);
    G[4] = CKEY(5, 0); G[5] = CKEY(5, 1); G[6] = CKEY(6, 0); G[7] = CKEY(6, 1); G[8] = CKEY(7, 0); G[9] = CKEY(7, 1);
#pragma unroll
    for (int i = 0; i < 6; ++i) G[10 + i] = CKEY(8 + i, 0);
    sort16_desc(G); top16_merge(C, G);
    insert16(C, CKEY(14, 0)); insert16(C, CKEY(15, 0));
#undef CKEY
    const float m = sort2f(C[0] & ~0xFFu); float e[16]; int id[16]; float sum = 0.f;
#pragma unroll
    for (int r = 0; r < 16; ++r) { e[r] = __expf(sort2f(C[r] & ~0xFFu) - m); sum += e[r]; const int code = 255 - (int)(C[r] & 0xFFu); id[r] = (int)tbl[(code >> 4) * 64] * 128 + (int)tbl[(16 + (code & 15)) * 64]; }
    const float inv = rcp_f(sum);
    if (hh == 0) { int* ip = F.IDX + (size_t)tok * 128 + h * 16;
#pragma unroll
        for (int k = 0; k < 4; ++k) { i32x4 w4;
#pragma unroll
            for (int j = 0; j < 4; ++j) w4[j] = (int)((pk2(0.f, e[4 * k + j] * inv) & 0xffff0000u) | (unsigned)id[4 * k + j]);
            *(GAS i32x4*)(ip + 4 * k) = w4; } }
}

__device__ __forceinline__ float ub0(unsigned w) { return (float)(w & 0xffu); }
__device__ __forceinline__ float ub1(unsigned w) { return (float)((w >> 8) & 0xffu); }
__device__ __forceinline__ float ub2(unsigned w) { return (float)((w >> 16) & 0xffu); }
__device__ __forceinline__ float ub3(unsigned w) { return (float)(w >> 24); }
constexpr int NSMAX = 132;
constexpr unsigned P10_DUMMY = 0xffffffffu;
#ifndef P10_FAKE_W
#define P10_FAKE_W 16384
#endif
__device__ __forceinline__ int pk_i8(float a, float b, float c, float d, float inv) {
    return (int)(((unsigned)(int)rintf(a * inv) & 0xffu) | (((unsigned)(int)rintf(b * inv) & 0xffu) << 8) | (((unsigned)(int)rintf(c * inv) & 0xffu) << 16) | (((unsigned)(int)rintf(d * inv) & 0xffu) << 24)); }
template <bool FAKE> __device__ __forceinline__ void peer_round(Frame& F, int quad) {
    constexpr bool U4 = P10_U4 != 0, V4 = P10_V4 != 0;
    const int lane = F.lane, grp = lane >> 4, i = lane & 15;
    const int tb = quad * 4;
    LAS v2u* lst = (LAS v2u*)(F.lds + F.wave * 4352);
#pragma unroll
    for (int tk = 0; tk < 4; ++tk) { const int t = tb + tk;
        const unsigned wa = (unsigned)F.IDX[(size_t)t * 128 + lane], wb = (unsigned)F.IDX[(size_t)t * 128 + 64 + lane];
        lst[tk * NSMAX + lane] = (v2u){wa & 0xffffu, wa & 0xffff0000u};
        lst[tk * NSMAX + 64 + lane] = (v2u){wb & 0xffffu, wb & 0xffff0000u};
        if (lane < NSMAX - 128) lst[tk * NSMAX + 128 + lane] = (v2u){(unsigned)F.IDX[(size_t)t * 128 + 127] & 0xffffu, 0u}; }
    const int NS = 129;
    const int t = tb + grp; int hq[16]; float sh;
#if G3_I8
    {
      static_assert(P10_U4 != 0, "the int8-activation path below is written for the 4-bit expert records");
      const unsigned char* hp = (const unsigned char*)F.XN + (size_t)t * DM + i * 32; sh = F.SA[t];
      const v4u h0 = *(const GAS v4u*)hp, h1 = *(const GAS v4u*)(hp + 16), h2 = *(const GAS v4u*)(hp + 512), h3 = *(const GAS v4u*)(hp + 528);
      const unsigned hw[16] = {h0.x, h0.y, h0.z, h0.w, h1.x, h1.y, h1.z, h1.w, h2.x, h2.y, h2.z, h2.w, h3.x, h3.y, h3.z, h3.w};
#pragma unroll
      for (int k = 0; k < 8; ++k) { unsigned hi_ = 0u, lo_ = 0u;
#pragma unroll
          for (int e = 0; e < 8; ++e) { const int qv = (int)(signed char)(hw[2 * k + (e >> 2)] >> (8 * (e & 3))); const int lo = ((qv + 8) & 15) - 8, hi = (qv - lo) >> 4; lo_ |= ((unsigned)lo & 15u) << (4 * e); hi_ |= ((unsigned)hi & 15u) << (4 * e); }
          hq[2 * k] = (int)hi_; hq[2 * k + 1] = (int)lo_; } }
#else
    { float hv[64]; float mx = 0.f;
      const int bq = t >> 13; const float* gmv = F.GM + (size_t)bq * 1024; const float* shv = F.MOD + (size_t)bq * 6144 + 3072;
      float ssv = F.SSQ[(size_t)t * 16 + i]; ssv += __shfl_xor(ssv, 1); ssv += __shfl_xor(ssv, 2); ssv += __shfl_xor(ssv, 4); ssv += __shfl_xor(ssv, 8);
      const float rstd = rsq_f(ssv * (1.f / DM) + EPS);
#pragma unroll
      for (int c8 = 0; c8 < 8; ++c8) { const int col = U4 ? ((c8 >> 2) * 512 + i * 32 + (c8 & 3) * 8) : ((c8 >> 1) * 256 + i * 16 + (c8 & 1) * 8); const bf16* hp = F.X1 + (size_t)t * DM + col;
          const v4u w = *(const GAS v4u*)hp; const unsigned ww[4] = {w.x, w.y, w.z, w.w};
          const f32x4 g0 = *(const GAS f32x4*)(gmv + col), g1 = *(const GAS f32x4*)(gmv + col + 4), s0 = *(const GAS f32x4*)(shv + col), s1 = *(const GAS f32x4*)(shv + col + 4);
          const float gg[8] = {g0.x, g0.y, g0.z, g0.w, g1.x, g1.y, g1.z, g1.w}, sv[8] = {s0.x, s0.y, s0.z, s0.w, s1.x, s1.y, s1.z, s1.w};
#pragma unroll
          for (int j = 0; j < 4; ++j) { const float lo = bflo(ww[j]) * rstd * gg[2 * j] + sv[2 * j], hi = bfhi(ww[j]) * rstd * gg[2 * j + 1] + sv[2 * j + 1]; hv[c8 * 8 + 2 * j] = lo; hv[c8 * 8 + 2 * j + 1] = hi; mx = fmaxf(mx, fmaxf(fabsf(lo), fabsf(hi))); } }
      mx = fmaxf(mx, __shfl_xor(mx, 1)); mx = fmaxf(mx, __shfl_xor(mx, 2)); mx = fmaxf(mx, __shfl_xor(mx, 4)); mx = fmaxf(mx, __shfl_xor(mx, 8));
      const float qmax = U4 ? 119.f : 127.f; const float inv = mx > 0.f ? qmax / mx : 0.f; sh = mx / qmax;
#pragma unroll
      for (int k = 0; k < 8; ++k) {
          if (U4) { unsigned hi_ = 0u, lo_ = 0u;
#pragma unroll
              for (int e = 0; e < 8; ++e) { const int qv = (int)rintf(hv[8 * k + e] * inv); const int lo = ((qv + 8) & 15) - 8, hi = (qv - lo) >> 4; lo_ |= ((unsigned)lo & 15u) << (4 * e); hi_ |= ((unsigned)hi & 15u) << (4 * e); }
              hq[2 * k] = (int)hi_; hq[2 * k + 1] = (int)lo_; }
          else { hq[2 * k] = pk_i8(hv[8 * k], hv[8 * k + 1], hv[8 * k + 2], hv[8 * k + 3], inv); hq[2 * k + 1] = pk_i8(hv[8 * k + 4], hv[8 * k + 5], hv[8 * k + 6], hv[8 * k + 7], inv); } } }
#endif
    float y[64]; float asum = 0.f, asum1 = 0.f;
#pragma unroll
    for (int k = 0; k < 64; ++k) y[k] = 0.f;
    LDS_WAIT();
    const LAS v2u* mylst = lst + grp * NSMAX;
#define P10_LOAD(r_, U, V, SU, SV, GT) do { const v2u kg_ = mylst[(r_)]; const int id0_ = (int)kg_.x; const int id_ = FAKE ? (int)((((unsigned)id0_ * 2654435761u) >> 7) & (P10_FAKE_W - 1)) : id0_; GT = __uint_as_float(kg_.y); \
        const unsigned char* ur_ = F.UT + (size_t)id_ * P10_REC; const unsigned char* vr_ = ur_ + P10_UB; \
        if (U4) { U[0] = *(const GAS v4u*)(ur_ + i * 16); U[1] = *(const GAS v4u*)(ur_ + 256 + i * 16); V[0] = *(const GAS v4u*)(vr_ + i * 16); V[1] = *(const GAS v4u*)(vr_ + 256 + i * 16); \
            const v2u sc_ = *(const GAS v2u*)(ur_ + 1024 + i * 8); SU = __uint_as_float(sc_.x); SV = __uint_as_float(sc_.y); }     \
        else { _Pragma("unroll") for (int sg = 0; sg < 4; ++sg) U[sg] = *(const GAS v4u*)(ur_ + sg * 256 + i * 16); SU = F.USC[id_]; \
            _Pragma("unroll") for (int sg = 0; sg < 4; ++sg) V[sg] = *(const GAS v4u*)(vr_ + sg * 256 + i * 16); SV = F.VSC[id_]; } } while (0)
#define P10_COMP(U, V, SU, SV, GT) do { float dact_; \
        if (U4) { const unsigned uw_[8] = {U[0].x, U[0].y, U[0].z, U[0].w, U[1].x, U[1].y, U[1].z, U[1].w}; int d0_ = 0, d1_ = 0; \
            int e0_ = 0, e1_ = 0; \
            _Pragma("unroll") for (int k = 0; k < 4; ++k) { d0_ = __builtin_amdgcn_sdot8((int)uw_[k], hq[2 * k], d0_, false); e0_ = __builtin_amdgcn_sdot8((int)uw_[k], hq[2 * k + 1], e0_, false); } \
            _Pragma("unroll") for (int k = 4; k < 8; ++k) { d1_ = __builtin_amdgcn_sdot8((int)uw_[k], hq[2 * k], d1_, false); e1_ = __builtin_amdgcn_sdot8((int)uw_[k], hq[2 * k + 1], e1_, false); } \
            const unsigned sb_ = __float_as_uint(SU); float df_ = bflo(sb_) * (float)(16 * d0_ + e0_) + bfhi(sb_) * (float)(16 * d1_ + e1_); \
            df_ += __shfl_xor(df_, 1); df_ += __shfl_xor(df_, 2); df_ += __shfl_xor(df_, 4); df_ += __shfl_xor(df_, 8); dact_ = df_ * sh; } \
        else { int d_ = 0; \
            _Pragma("unroll") for (int sg = 0; sg < 4; ++sg) { d_ = __builtin_amdgcn_sdot4((int)U[sg].x, hq[sg * 4], d_, false); d_ = __builtin_amdgcn_sdot4((int)U[sg].y, hq[sg * 4 + 1], d_, false); d_ = __builtin_amdgcn_sdot4((int)U[sg].z, hq[sg * 4 + 2], d_, false); d_ = __builtin_amdgcn_sdot4((int)U[sg].w, hq[sg * 4 + 3], d_, false); } \
            d_ += __shfl_xor(d_, 1); d_ += __shfl_xor(d_, 2); d_ += __shfl_xor(d_, 4); d_ += __shfl_xor(d_, 8); dact_ = (float)d_ * (SU * sh); } \
        const float ag_ = gelu_fast(dact_) * GT; \
        if (V4) { const unsigned vb_ = __float_as_uint(SV); const float a0_ = ag_ * bflo(vb_), a1_ = ag_ * bfhi(vb_); asum += a0_; asum1 += a1_; \
            const unsigned vw_[8] = {V[0].x, V[0].y, V[0].z, V[0].w, V[1].x, V[1].y, V[1].z, V[1].w}; \
            _Pragma("unroll") for (int k = 0; k < 8; ++k) { const unsigned lo_ = vw_[k]; unsigned hi_ = vw_[k] & 0xf0f0f0f0u; asm volatile("" : "+v"(hi_));        \
                const float a_ = k < 4 ? a0_ : a1_;   \
                y[8 * k] += a_ * ub0(lo_); y[8 * k + 1] += a_ * ub1(lo_); y[8 * k + 2] += a_ * ub2(lo_); y[8 * k + 3] += a_ * ub3(lo_); y[8 * k + 4] += a_ * ub0(hi_); y[8 * k + 5] += a_ * ub1(hi_); y[8 * k + 6] += a_ * ub2(hi_); y[8 * k + 7] += a_ * ub3(hi_); } } \
        else { const float a_ = ag_ * SV; asum += a_; \
            _Pragma("unroll") for (int sg = 0; sg < 4; ++sg) { const unsigned xw_[4] = {V[sg].x, V[sg].y, V[sg].z, V[sg].w}; \
                _Pragma("unroll") for (int j = 0; j < 4; ++j) { y[sg * 16 + 4 * j] += a_ * ub0(xw_[j]); y[sg * 16 + 4 * j + 1] += a_ * ub1(xw_[j]); y[sg * 16 + 4 * j + 2] += a_ * ub2(xw_[j]); y[sg * 16 + 4 * j + 3] += a_ * ub3(xw_[j]); } } } } while (0)
#ifndef P10_DEPTH
#define P10_DEPTH 2
#endif
#ifndef P10_FENCED
#define P10_FENCED 0
#endif
#define P10_FENCE do { if (P10_FENCED) __builtin_amdgcn_sched_barrier(0); } while (0)
    if (P10_DEPTH == 3) {
        v4u uA[4], vA[4], uB[4], vB[4], uC[4], vC[4]; float suA, svA, suB, svB, suC, svC, gtA, gtB, gtC;
        const int last = NS - 1;
        P10_LOAD(0, uA, vA, suA, svA, gtA); P10_LOAD(1, uB, vB, suB, svB, gtB);
#pragma unroll 1
        for (int r = 0; r < NS; r += 3) {
            { const int rn = r + 2; P10_LOAD(rn, uC, vC, suC, svC, gtC); } P10_FENCE;
            P10_COMP(uA, vA, suA, svA, gtA); P10_FENCE;
            { const int rn = r + 3 < NS ? r + 3 : last; P10_LOAD(rn, uA, vA, suA, svA, gtA); } P10_FENCE;
            P10_COMP(uB, vB, suB, svB, gtB); P10_FENCE;
            { const int rn = r + 4 < NS ? r + 4 : last; P10_LOAD(rn, uB, vB, suB, svB, gtB); } P10_FENCE;
            P10_COMP(uC, vC, suC, svC, gtC); P10_FENCE;
        }
    } else if (P10_DEPTH == 4) {
        v4u uA[4], vA[4], uB[4], vB[4], uC[4], vC[4], uD[4], vD[4]; float suA, svA, suB, svB, suC, svC, suD, svD, gtA, gtB, gtC, gtD;
        P10_LOAD(0, uA, vA, suA, svA, gtA); P10_LOAD(1, uB, vB, suB, svB, gtB); P10_LOAD(2, uC, vC, suC, svC, gtC);
#pragma unroll 1
        for (int r = 0; r < 128; r += 4) {
            { const int rn = r + 3; P10_LOAD(rn, uD, vD, suD, svD, gtD); } P10_FENCE;
            P10_COMP(uA, vA, suA, svA, gtA); P10_FENCE;
            { const int rn = r + 4 < 128 ? r + 4 : 127; P10_LOAD(rn, uA, vA, suA, svA, gtA); } P10_FENCE;
            P10_COMP(uB, vB, suB, svB, gtB); P10_FENCE;
            { const int rn = r + 5 < 128 ? r + 5 : 127; P10_LOAD(rn, uB, vB, suB, svB, gtB); } P10_FENCE;
            P10_COMP(uC, vC, suC, svC, gtC); P10_FENCE;
            { const int rn = r + 6 < 128 ? r + 6 : 127; P10_LOAD(rn, uC, vC, suC, svC, gtC); } P10_FENCE;
            P10_COMP(uD, vD, suD, svD, gtD); P10_FENCE;
        }
    } else {
        v4u uA[4], vA[4], uB[4], vB[4]; float suA, svA, suB, svB, gtA, gtB;
        P10_LOAD(0, uA, vA, suA, svA, gtA);
#pragma unroll 1
        for (int r = 0; r < 128; r += 2) {
            { const int rn = r + 1; P10_LOAD(rn, uB, vB, suB, svB, gtB); } P10_FENCE;
            P10_COMP(uA, vA, suA, svA, gtA); P10_FENCE;
            { const int rn = r + 2 < 128 ? r + 2 : 127; P10_LOAD(rn, uA, vA, suA, svA, gtA); } P10_FENCE;
            P10_COMP(uB, vB, suB, svB, gtB); P10_FENCE;
        }
    }
#define P10_YI(m, j) (V4 ? (8 * ((m) >> 1) + 2 * ((m) & 1) + ((j) >> 1) + 4 * ((j) & 1)) : (4 * (m) + (j)))
    { const int b = t >> 13; const float* g2 = F.MOD + (size_t)b * 6144 + 5120; const bf16* xr2 = F.X1 + (size_t)t * DM; float ss = 0.f;
#pragma unroll
      for (int m = 0; m < 16; ++m) { const int col = V4 ? ((m >> 3) * 512 + i * 32 + 4 * (m & 7)) : ((m >> 2) * 256 + i * 16 + 4 * (m & 3)); const float yoff = V4 ? 8.f * (m < 8 ? asum : asum1) : 128.f * asum;
          const v2u xw = *(const GAS v2u*)(xr2 + col); const f32x4 ga = *(const GAS f32x4*)(g2 + col); const float xs[4] = {bflo(xw.x), bfhi(xw.x), bflo(xw.y), bfhi(xw.y)}, gs[4] = {ga.x, ga.y, ga.z, ga.w};
          float yv[4];
#pragma unroll
          for (int j = 0; j < 4; ++j) yv[j] = !V4 ? y[P10_YI(m, j)] : ((j & 1) ? y[P10_YI(m, j)] * 0.0625f : y[P10_YI(m, j)] - y[P10_YI(m, j + 1)]);
#pragma unroll
          for (int j = 0; j < 4; ++j) { const float zz = xs[j] + gs[j] * (yv[j] - yoff); y[P10_YI(m, j)] = zz; ss += zz * zz; } }
      ss += __shfl_xor(ss, 1); ss += __shfl_xor(ss, 2); ss += __shfl_xor(ss, 4); ss += __shfl_xor(ss, 8);
      const float rs = rsq_f(ss * (1.f / DM) + EPS); const float* fg = F.final_g; float* orow = F.out + (size_t)t * DM;
      if (FAKE) { if (i == 0) F.DEC[t] = rs + y[3]; }
      else {
#pragma unroll
      for (int m = 0; m < 16; ++m) { const int col = V4 ? ((m >> 3) * 512 + i * 32 + 4 * (m & 7)) : ((m >> 2) * 256 + i * 16 + 4 * (m & 3)); const f32x4 fa = *(const GAS f32x4*)(fg + col);
          *(GAS f32x4*)(orow + col) = (f32x4){y[P10_YI(m, 0)] * rs * fa.x, y[P10_YI(m, 1)] * rs * fa.y, y[P10_YI(m, 2)] * rs * fa.z, y[P10_YI(m, 3)] * rs * fa.w}; } } }
    LDS_WAIT();
}

struct Args { const float* in[20]; float* out; unsigned char* ws; int ph_lo, ph_hi, li, pad; };
__global__ void __launch_bounds__(NWAVES * 64, 2) hymba_fwd(Args args) {
    extern __shared__ __attribute__((aligned(16))) unsigned char lds[];
    Frame F;
    F.lds = (LAS unsigned char*)lds;
    F.MISC = (volatile LAS unsigned*)(F.lds + MISC_OFF);
    F.tid = threadIdx.x; F.lane = F.tid & 63; F.wave = __builtin_amdgcn_readfirstlane(F.tid >> 6);
    F.G = gridDim.x; { const int bx = blockIdx.x; F.vcu = (F.G % 8 == 0) ? (bx % 8) * (F.G / 8) + bx / 8 : bx; }
    unsigned char* ws = args.ws;
    F.ctl = (gu32*)(ws + WS_CTL);
    F.x = args.in[0]; F.c = args.in[1]; F.ada_w = args.in[2]; F.ada_b = args.in[3]; F.norm1_g = args.in[4]; F.w_in = args.in[5]; F.lb_gamma = args.in[6]; F.hgrn_g = args.in[7];
    F.ln_g = args.in[8]; F.ln_b = args.in[9]; F.sp_w = args.in[10]; F.sp_b = args.in[11]; F.gm_g = args.in[12]; F.w_out = args.in[13]; F.norm2_g = args.in[14]; F.wq = args.in[15];
    F.keys = args.in[16]; F.pu = args.in[17]; F.pv = args.in[18]; F.final_g = args.in[19]; F.out = args.out;
    F.MODP = (float*)(ws + WS_MODP); F.MOD = (float*)(ws + WS_MOD); F.LB = (float*)(ws + WS_LB); F.SW = (float*)(ws + WS_SW); F.SA = (float*)(ws + WS_SA); F.DEC = (float*)(ws + WS_DEC); F.X1 = (bf16*)(ws + WS_X1); F.GATE = (float*)(ws + WS_GATE); F.IDX = (int*)(ws + WS_IDX);
    F.WIN = (bf16*)(ws + WS_WIN); F.WOUT = (bf16*)(ws + WS_WOUT); F.WQ = (bf16*)(ws + WS_WQ); F.KEYS = (bf16*)(ws + WS_KEYS); F.SPW = (bf16*)(ws + WS_SPW);
    F.UT = ws + WS_UT; F.VT = ws + WS_VT; F.USC = (float*)(ws + WS_USC); F.VSC = (float*)(ws + WS_VSC); F.XN = (bf16*)(ws + WS_XN); F.PROJ = (bf16*)(ws + WS_PROJ); F.QB = (bf16*)(ws + WS_PROJ);
    F.STATE = (bf16*)(ws + WS_STATE); F.CAT = (bf16*)(ws + WS_CAT);
    F.QBIAS = (float*)(ws + WS_QBIAS); F.GM = (float*)(ws + WS_GM); F.SSQ = (float*)(ws + WS_SSQ); F.WQF = (bf16*)(ws + WS_WQF);
    for (int u = F.tid; u < (LDS_BYTES - LDSCTL_OFF) / 4; u += NWAVES * 64) ((LAS unsigned*)(F.lds + LDSCTL_OFF))[u] = 0u;
    __syncthreads();
    XcdBarrier bar; bar.bar = (unsigned*)(F.ctl + CW_BAR); bar.x = 0; bar.st = nullptr;
    if (!MK_PER_PHASE) bar = xcd_barrier_post((unsigned*)(F.ctl + CW_BAR), F.MISC + 8);
    const int lo = args.ph_lo, hi = args.ph_hi;
#ifndef PHMASK
#define PHMASK 0x7ff
#endif
#define IN(k) (((PHMASK >> (k)) & 1) && lo <= (k) && (k) < hi)
#define SEAM(k) do { if (IN(k) && IN((k) + 1)) xcd_barrier(bar); } while (0)

#ifndef PHREP
#define PHREP 0
#endif
#ifndef P10_HALF
#define P10_HALF 0
#endif
#define REP2(k) ((PHREP >> (k)) & 1)
#define PH0 do { p0_prologue(F); __syncthreads(); } while (0)
#define PH1 do { p1_norm1(F); __syncthreads(); } while (0)
#if G1_I8
#define PH2 do { pg8::Gemm g{F.XN, F.WIN, T, NPROJ, DM / 2};     \
        pg8::StaticOrder S; S.init(T, NPROJ, F.G, (int)blockIdx.x); pg8::EpiBf16S E{F.PROJ, NPROJ, F.SA, F.SW}; \
        pg8::gemm_phase<pg8::EpiBf16S, pg8::StaticOrder, true, true, true>(F.lds, g, S, E); } while (0)
#else
#define PH2 do { pg8::Gemm g{F.XN, F.WIN, T, NPROJ, DM}; pg8::StaticOrder S; S.init(T, NPROJ, F.G, (int)blockIdx.x); pg8::EpiBf16 E{F.PROJ, NPROJ}; \
        pg8::gemm_phase<pg8::EpiBf16, pg8::StaticOrder, true, true>(F.lds, g, S, E); } while (0)
#endif
#define PH3A do { HRawA ra_, rb_; hgrnA_load(F, F.vcu, ra_);        \
        for (int u = F.vcu; u < 2048; u += 2 * F.G) { hgrnA_load(F, u + F.G, rb_); hgrnA_unit(F, u, ra_); hgrnA_load(F, u + 2 * F.G < 2048 ? u + 2 * F.G : u, ra_); hgrnA_unit(F, u + F.G, rb_); } } while (0)
#define PH3 do { PH3A; for (int u = F.vcu; u < 256; u += F.G) gmlp_unit(F, u); } while (0)
#define PH5 do { HRawC ra_, rb_; hgrnC_load(F, F.vcu, ra_);        \
        for (int u = F.vcu; u < 2048; u += 2 * F.G) { hgrnC_load(F, u + F.G, rb_); hgrnC_unit(F, u, ra_); hgrnC_load(F, u + 2 * F.G < 2048 ? u + 2 * F.G : u, ra_); hgrnC_unit(F, u + F.G, rb_); } } while (0)
#define PH6 do { pg8::Gemm g{F.CAT, F.WOUT, T, DM, DM}; pg8::StaticOrder S; S.init(T, DM, F.G, (int)blockIdx.x); pg8::EpiResid E{F.x, F.X1, F.MOD + 2048, 6144, SEQ, DM, F.SSQ}; \
        pg8::gemm_phase<pg8::EpiResid, pg8::StaticOrder, true, true>(F.lds, g, S, E); } while (0)
#define PH7 do { } while (0)
#if G3_I8
#define PH8 do { pg8::Gemm g{F.XN, F.WQ, T, NQ, DM / 2}; pg8::StaticOrder S; S.init(T, NQ, F.G, (int)blockIdx.x); pg8::EpiBf16S E{F.QB, NQ, F.SA, F.SW + NPROJ}; \
        pg8::gemm_phase<pg8::EpiBf16S, pg8::StaticOrder, true, true, true>(F.lds, g, S, E); } while (0)
#else
#define PH8 do { pg8::Gemm g{F.X1, F.WQF, T, NQ, DM, 5};        \
        pg8::StaticOrder S; S.init(T, NQ, F.G, (int)blockIdx.x); pg8::EpiQ E{F.QB, NQ, F.SSQ, F.QBIAS, 5}; \
        pg8::gemm_phase<pg8::EpiQ, pg8::StaticOrder, true, true>(F.lds, g, S, E); } while (0)
#endif
#define PH9 do {   \
        pg8::StaticOrder S9_; S9_.init(T, NQ, F.G, (int)blockIdx.x); pg8::Unit u9_; \
        for (int i9_ = 0; S9_.next(i9_, u9_); ++i9_) { const int h_ = u9_.pn; QRaw q9_; route_load(F, u9_.pm * 8 + F.wave, h_, q9_);        \
            { v4u kv_[8]; \
              _Pragma("unroll") for (int j_ = 0; j_ < 8; ++j_) { const int c_ = F.tid + 512 * j_; kv_[j_] = *(const GAS v4u*)(F.KEYS + (size_t)(h_ * 256 + (c_ >> 4)) * 128 + (c_ & 15) * 8); } \
              _Pragma("unroll") for (int j_ = 0; j_ < 8; ++j_) { const int c_ = F.tid + 512 * j_; *(LAS v4u*)((LAS unsigned short*)F.lds + (c_ >> 4) * 136 + (c_ & 15) * 8) = kv_[j_]; } } \
            __syncthreads(); \
            route_job(F, u9_.pm * 8 + F.wave, h_, q9_); __syncthreads(); } } while (0)
    if (IN(0)) { PH0; if (REP2(0)) PH0; } SEAM(0);
    if (IN(1)) { PH1; if (REP2(1)) PH1; } SEAM(1);
    if (IN(2)) { PH2; if (REP2(2)) PH2; } SEAM(2);
    if (IN(3)) { PH3; if (REP2(3)) { PH3A; } if (REP2(11)) { for (int u = F.vcu; u < 256; u += F.G) gmlp_unit(F, u); } } SEAM(3);
#ifndef XBARS
#define XBARS 0
#endif
    if (IN(4)) { p4_qbias(F); p4_scan(F); if (REP2(4)) p4_scan(F); for (int xb = 0; xb < XBARS; ++xb) xcd_barrier(bar); } SEAM(4);
    if (IN(5)) { PH5; if (REP2(5)) PH5; } SEAM(5);
    if (IN(6)) { PH6; if (REP2(6)) PH6; } SEAM(6);
    if (IN(8)) { PH8; if (REP2(8)) PH8; VM_WAIT(); __syncthreads(); }
    if (IN(9)) { PH9; if (REP2(9)) PH9; } SEAM(9);
    if (IN(10)) {
        const int gw = F.vcu * NWAVES + F.wave;
        if (REP2(10)) { for (int rd = 0; rd < 4; ++rd) peer_round<false>(F, rd * 2048 + gw); }
#if P10_HALF
        if (F.vcu & 1) return;
        peer_round<false>(F, gw + NWAVES);
#endif
        int q = gw;
        while (q < T / 4) { peer_round<false>(F, q);
            int nq = 0; if (F.lane == 0) nq = (int)__hip_atomic_fetch_add(F.ctl + 16, 1u, __ATOMIC_RELAXED, __HIP_MEMORY_SCOPE_AGENT);
            q = F.G * NWAVES + __builtin_amdgcn_readfirstlane(nq); }
    }
#undef IN
#undef SEAM
}

extern "C" void kernel_launch(void* const* d_in, const int* in_sizes, int n_in, void* d_out, int out_size, void* d_ws, size_t ws_size, hipStream_t stream) {
    static int grid = 0;
    if (grid == 0) {
        if (n_in != 20 || in_sizes[0] != T * DM || out_size != T * DM || ws_size < WS_END) { fprintf(stderr, "kernel_launch: unexpected shapes (n_in %d, in0 %d, out %d, ws %zu); nothing launched\n", n_in, n_in > 0 ? in_sizes[0] : -1, out_size, ws_size); grid = -1; return; }
        if (hipFuncSetAttribute((const void*)hymba_fwd, hipFuncAttributeMaxDynamicSharedMemorySize, LDS_BYTES) != hipSuccess) { fprintf(stderr, "kernel_launch: hipFuncSetAttribute failed\n"); grid = -1; return; }
        int per_cu = 0;
        if (hipOccupancyMaxActiveBlocksPerMultiprocessor(&per_cu, (const void*)hymba_fwd, NWAVES * 64, LDS_BYTES) != hipSuccess || per_cu < 1)
            fprintf(stderr, "kernel_launch: note: occupancy query reports %d workgroups per CU\n", per_cu);
        (void)hipGetLastError();
        grid = 256;
    }
    if (grid < 0) return;
    if (hipMemsetAsync((char*)d_ws + WS_CTL, 0, CTL_ZERO_BYTES, stream) != hipSuccess) { fprintf(stderr, "kernel_launch: hipMemsetAsync failed\n"); return; }
    Args a{};
    for (int i = 0; i < 20; ++i) a.in[i] = (const float*)d_in[i];
    a.out = (float*)d_out; a.ws = (unsigned char*)d_ws;
#if MK_PER_PHASE
    for (int li = 0; li < NPHASE; ++li) { a.ph_lo = li; a.ph_hi = li + 1; a.li = li; hipLaunchKernelGGL(hymba_fwd, dim3(grid), dim3(NWAVES * 64), LDS_BYTES, stream, a); }
#else
    a.ph_lo = 0; a.ph_hi = NPHASE; a.li = 0; hipLaunchKernelGGL(hymba_fwd, dim3(grid), dim3(NWAVES * 64), LDS_BYTES, stream, a);
#endif
    const hipError_t le = hipPeekAtLastError();
    if (le != hipSuccess) fprintf(stderr, "kernel_launch: launch failed: %s\n", hipGetErrorName(le));
}
```

```cpp
#include <hip/hip_runtime.h>
#include <cstdio>
#include <cstdint>
namespace pg8 {
#define PG8_LAS __attribute__((address_space(3)))
typedef unsigned short bf16_t;
typedef short bf16x8 __attribute__((ext_vector_type(8)));
typedef float f32x4 __attribute__((ext_vector_type(4)));
typedef unsigned u32x4 __attribute__((ext_vector_type(4)));
constexpr int BM = 256, BK = 64, HALF = 128, HTB = HALF * BK * 2  , STAGE_BYTES = 8 * HTB, NXCD = 8, WGM = 8;

__host__ __device__ __forceinline__ int lds_byte(int r, int c) { const int st = (r >> 4) * 2 + (c >> 5), rr = r & 15, cc = c & 31, ob = rr * 64 + cc * 2; return st * 1024 + (ob ^ (((ob >> 9) & 1) << 5)); }
__host__ __device__ __forceinline__ void stage_rc(int b, int& R, int& C) { const int st = b / 1024, sb = b % 1024, swz = sb ^ (((sb >> 9) & 1) << 5); R = (st >> 1) * 16 + swz / 64; C = (st & 1) * 32 + (swz % 64) / 2; }
__host__ __device__ __forceinline__ int perm32(int rho) { const int n = rho >> 4, i = rho & 15; return 8 * (i >> 2) + 4 * n + (i & 3); }

struct Unit { int pm, pn; };
struct Gemm { const bf16_t* A; const bf16_t* Bt; int M, N, K; int bsh = -1; };

struct StaticOrder {
    int nM, nN, nwg, G, c;
    __host__ __device__ void init(int M, int N, int G_, int c_) { nM = M / BM; nN = N / BM; nwg = nM * nN; G = G_; c = c_; }
    __host__ __device__ bool next(int i, Unit& u) const {
        const long L = (long)i * G + c; if (L >= nwg) return false;
        int wgid = (int)L; { const int q = nwg / NXCD, r = nwg % NXCD, xcd = wgid % NXCD, off = wgid / NXCD; wgid = (xcd < r ? xcd * (q + 1) : r * (q + 1) + (xcd - r) * q) + off; }
        const int nig = WGM * nN, gid = wgid / nig, fm = gid * WGM, gsz = (nM - fm) < WGM ? (nM - fm) : WGM;
        u.pm = fm + ((wgid % nig) % gsz); u.pn = (wgid % nig) / gsz; return true;
    }
    __device__ __forceinline__ void a_ready(const Unit&) const {}
    __device__ __forceinline__ void done(const Unit&) const {}
};

__device__ __forceinline__ unsigned cvt_pk_bf16(float lo, float hi) { unsigned r; asm volatile("v_cvt_pk_bf16_f32 %0, %1, %2" : "=v"(r) : "v"(lo), "v"(hi)); return r; }
typedef float f32x2 __attribute__((ext_vector_type(2)));

struct EpiBf16 {
    static constexpr bool PERM = true, AFTER_DRAIN = false;
    bf16_t* O; int ldc;
    __device__ __forceinline__ void operator()(const f32x4 (&acc)[2][2][4][2], const Unit& u, int wr, int wc, int fr, int fq) const {
        const int row0 = u.pm * BM + wr * 64 + fr; const int col0 = u.pn * BM + wc * 32 + 8 * fq;
#pragma unroll
        for (int ai = 0; ai < 2; ++ai)
#pragma unroll
            for (int m = 0; m < 4; ++m) { bf16_t* rowp = O + (size_t)(row0 + ai * HALF + m * 16) * ldc + col0;
#pragma unroll
                for (int bj = 0; bj < 2; ++bj) { const f32x4 v0 = acc[ai][bj][m][0], v1 = acc[ai][bj][m][1];
                    u32x4 w; w.x = cvt_pk_bf16(v0[0], v0[1]); w.y = cvt_pk_bf16(v0[2], v0[3]); w.z = cvt_pk_bf16(v1[0], v1[1]); w.w = cvt_pk_bf16(v1[2], v1[3]);
                    *(u32x4*)(rowp + bj * HALF) = w; } }
    }
};
struct EpiBf16S {
    static constexpr bool PERM = true, AFTER_DRAIN = false;
    bf16_t* O; int ldc; const float* sa; const float* sw;
    __device__ __forceinline__ void operator()(const f32x4 (&acc)[2][2][4][2], const Unit& u, int wr, int wc, int fr, int fq) const {
        const int row0 = u.pm * BM + wr * 64 + fr; const int col0 = u.pn * BM + wc * 32 + 8 * fq;
        f32x4 cs[2][2];
#pragma unroll
        for (int bj = 0; bj < 2; ++bj)
#pragma unroll
            for (int n = 0; n < 2; ++n) cs[bj][n] = *(const f32x4*)(sw + col0 + bj * HALF + 4 * n);
#pragma unroll
        for (int ai = 0; ai < 2; ++ai)
#pragma unroll
            for (int m = 0; m < 4; ++m) { const int row = row0 + ai * HALF + m * 16; const float rs = sa[row]; bf16_t* rowp = O + (size_t)row * ldc + col0;
#pragma unroll
                for (int bj = 0; bj < 2; ++bj) { const f32x4 v0 = acc[ai][bj][m][0] * cs[bj][0] * rs, v1 = acc[ai][bj][m][1] * cs[bj][1] * rs;
                    u32x4 w; w.x = cvt_pk_bf16(v0[0], v0[1]); w.y = cvt_pk_bf16(v0[2], v0[3]); w.z = cvt_pk_bf16(v1[0], v1[1]); w.w = cvt_pk_bf16(v1[2], v1[3]);
                    *(u32x4*)(rowp + bj * HALF) = w; } }
    }
};
struct EpiResid {
    static constexpr bool PERM = true, AFTER_DRAIN = false;
    const float* xin; bf16_t* out; const float* gate; int gate_stride; int rows_per_batch; int ldc; float* ssq;
    __device__ __forceinline__ void operator()(const f32x4 (&acc)[2][2][4][2], const Unit& u, int wr, int wc, int fr, int fq) const {
        const int row0 = u.pm * BM + wr * 64 + fr; const int col0 = u.pn * BM + wc * 32 + 8 * fq;
        const float* gp = gate + (size_t)((u.pm * BM) / rows_per_batch) * gate_stride + col0;
        f32x4 gv[2][2];
#pragma unroll
        for (int bj = 0; bj < 2; ++bj)
#pragma unroll
            for (int n = 0; n < 2; ++n) gv[bj][n] = *(const f32x4*)(gp + bj * HALF + 4 * n);
#pragma unroll
        for (int ai = 0; ai < 2; ++ai)
#pragma unroll
            for (int m = 0; m < 4; ++m) { const int row = row0 + ai * HALF + m * 16; const size_t off = (size_t)row * ldc + col0; float s2 = 0.f;
#pragma unroll
                for (int bj = 0; bj < 2; ++bj) { const f32x4 x0 = *(const f32x4*)(xin + off + bj * HALF), x1 = *(const f32x4*)(xin + off + bj * HALF + 4);
                    const f32x4 v0 = x0 + gv[bj][0] * acc[ai][bj][m][0], v1 = x1 + gv[bj][1] * acc[ai][bj][m][1];
                    s2 += (v0[0] * v0[0] + v0[1] * v0[1]) + (v0[2] * v0[2] + v0[3] * v0[3]) + (v1[0] * v1[0] + v1[1] * v1[1]) + (v1[2] * v1[2] + v1[3] * v1[3]);
                    u32x4 w; w.x = cvt_pk_bf16(v0[0], v0[1]); w.y = cvt_pk_bf16(v0[2], v0[3]); w.z = cvt_pk_bf16(v1[0], v1[1]); w.w = cvt_pk_bf16(v1[2], v1[3]);
                    *(u32x4*)(out + off + bj * HALF) = w; }
                s2 += __shfl_xor(s2, 16); s2 += __shfl_xor(s2, 32);
                if (fq == 0) ssq[(size_t)row * 16 + u.pn * 4 + wc] = s2; }
    }
};
struct EpiQ {
    static constexpr bool PERM = true, AFTER_DRAIN = false;
    bf16_t* O; int ldc; const float* ssq; const float* bias; int bsh;
    __device__ __forceinline__ void operator()(const f32x4 (&acc)[2][2][4][2], const Unit& u, int wr, int wc, int fr, int fq) const {
        const int row0 = u.pm * BM + wr * 64 + fr; const int col0 = u.pn * BM + wc * 32 + 8 * fq;
        const float* bp = bias + (size_t)(u.pm >> bsh) * ldc + col0;
        f32x4 bv[2][2];
#pragma unroll
        for (int bj = 0; bj < 2; ++bj)
#pragma unroll
            for (int n = 0; n < 2; ++n) bv[bj][n] = *(const f32x4*)(bp + bj * HALF + 4 * n);
#pragma unroll
        for (int ai = 0; ai < 2; ++ai)
#pragma unroll
            for (int m = 0; m < 4; ++m) { const int row = row0 + ai * HALF + m * 16; const f32x4* sp = (const f32x4*)(ssq + (size_t)row * 16);
                const f32x4 sa = (sp[0] + sp[1]) + (sp[2] + sp[3]); const float rs = __builtin_amdgcn_rsqf(((sa[0] + sa[1]) + (sa[2] + sa[3])) * (1.f / 1024.f) + 1e-6f);
                bf16_t* rowp = O + (size_t)row * ldc + col0;
#pragma unroll
                for (int bj = 0; bj < 2; ++bj) { const f32x4 v0 = acc[ai][bj][m][0] * rs + bv[bj][0], v1 = acc[ai][bj][m][1] * rs + bv[bj][1];
                    u32x4 w; w.x = cvt_pk_bf16(v0[0], v0[1]); w.y = cvt_pk_bf16(v0[2], v0[3]); w.z = cvt_pk_bf16(v1[0], v1[1]); w.w = cvt_pk_bf16(v1[2], v1[3]);
                    *(u32x4*)(rowp + bj * HALF) = w; } }
    }
};

typedef int i32x4 __attribute__((ext_vector_type(4)));
template <bool I8> __device__ __forceinline__ f32x4 mma16(const bf16x8 b, const bf16x8 a, const f32x4 c) {
    if constexpr (I8) return __builtin_bit_cast(f32x4, __builtin_amdgcn_mfma_i32_16x16x64_i8(__builtin_bit_cast(i32x4, b), __builtin_bit_cast(i32x4, a), __builtin_bit_cast(i32x4, c), 0, 0, 0));
    else return __builtin_amdgcn_mfma_f32_16x16x32_bf16(b, a, c, 0, 0, 0);
}
template <class Epi, class Sched, bool ALIGN_EPI = false, bool SP2 = false, bool I8 = false>
__device__ __forceinline__ void gemm_phase(PG8_LAS unsigned char* lds, const Gemm g, const Sched& S, const Epi& E) {
    const int tid = threadIdx.x, wid = __builtin_amdgcn_readfirstlane(tid >> 6), lane = tid & 63, wr = wid >> 2, wc = wid & 3, fr = lane & 15, fq = lane >> 4;
    const int K = g.K, nt = K / BK;
    unsigned voffA[2], voffB[2];
#pragma unroll
    for (int i = 0; i < 2; ++i) { int R, C; stage_rc(tid * 16 + i * 8192, R, C); const int Rb = Epi::PERM ? ((R & ~31) + perm32(R & 31)) : R;
        voffA[i] = (unsigned)(R * K + C) * 2u; voffB[i] = (unsigned)(Rb * K + C) * 2u; }
    const size_t kstep = (size_t)(BK * 2);
    const size_t hstep = (size_t)HALF * K * 2;
    const size_t tstep = 2 * hstep;
    const unsigned ldsw = (unsigned)wid * 1024u;
    const int aoff = lds_byte(wr * 64 + fr, fq * 8), boff = lds_byte(wc * 32 + fr, fq * 8);
#define PG8_SA(b, h) (((b) * 2 + (h)) * HTB)
#define PG8_SB(b, h) ((4 + (b) * 2 + (h)) * HTB)
#define PG8_STAGE(bufoff, gbase, voff) do { _Pragma("unroll") for (int _i = 0; _i < 2; ++_i) \
        __builtin_amdgcn_global_load_lds((const unsigned*)((const char*)(gbase) + (voff)[_i]), (PG8_LAS unsigned*)(lds + (bufoff) + ldsw + _i * 8192), 16, 0, 0); } while (0)
#define PG8_LDA(dst, b, h) do { _Pragma("unroll") for (int m = 0; m < 4; ++m) _Pragma("unroll") for (int k = 0; k < 2; ++k) dst[m][k] = *(const PG8_LAS bf16x8*)(lds + PG8_SA(b, h) + aoff + m * 2048 + k * 1024); } while (0)
#define PG8_LDB(dst, b, h) do { _Pragma("unroll") for (int n = 0; n < 2; ++n) _Pragma("unroll") for (int k = 0; k < 2; ++k) dst[n][k] = *(const PG8_LAS bf16x8*)(lds + PG8_SB(b, h) + boff + n * 2048 + k * 1024); } while (0)
#define PG8_MMA(ai, bj, At, Bt) do { __builtin_amdgcn_s_setprio(1); _Pragma("unroll") for (int m = 0; m < 4; ++m) _Pragma("unroll") for (int n = 0; n < 2; ++n) _Pragma("unroll") for (int k = 0; k < 2; ++k) \
        acc[ai][bj][m][n] = mma16<I8>(Bt[n][k], At[m][k], acc[ai][bj][m][n]); __builtin_amdgcn_s_setprio(0); } while (0)
#define PG8_WAIT_V(n) asm volatile("s_waitcnt vmcnt(" #n ")" ::: "memory")
#define PG8_WAIT_L(n) asm volatile("s_waitcnt lgkmcnt(" #n ")" ::: "memory")
#define PG8_BAR __builtin_amdgcn_s_barrier()
#define PG8_SCHED __builtin_amdgcn_sched_barrier(0)
    Unit cur, nxt; int ui = 0;
    if (!S.next(0, cur)) return;
    f32x4 acc[2][2][4][2];
#pragma unroll
    for (int a = 0; a < 2; ++a)
#pragma unroll
        for (int b = 0; b < 2; ++b)
#pragma unroll
            for (int m = 0; m < 4; ++m)
#pragma unroll
                for (int n = 0; n < 2; ++n) acc[a][b][m][n] = (f32x4){0.f, 0.f, 0.f, 0.f};
    bf16x8 At[4][2], B0[2][2], B1[2][2];
    const char* cA = (const char*)g.A + (size_t)cur.pm * tstep; const char* cB = (const char*)g.Bt + (size_t)(cur.pn + (g.bsh >= 0 ? (cur.pm >> g.bsh) * (g.N / BM) : 0)) * tstep;
    S.a_ready(cur);
    if constexpr (SP2) {
        PG8_STAGE(PG8_SB(0, 0), cB, voffB); PG8_STAGE(PG8_SB(0, 1), cB + hstep, voffB); PG8_STAGE(PG8_SA(0, 0), cA, voffA); PG8_STAGE(PG8_SA(0, 1), cA + hstep, voffA);
        if (wr == 1) PG8_BAR;
        PG8_WAIT_V(2); PG8_BAR;
        PG8_STAGE(PG8_SB(1, 0), cB + kstep, voffB); PG8_STAGE(PG8_SA(1, 0), cA + kstep, voffA); PG8_STAGE(PG8_SB(1, 1), cB + hstep + kstep, voffB);
        PG8_WAIT_V(6); PG8_BAR;
    } else {
        PG8_STAGE(PG8_SB(0, 0), cB, voffB); PG8_STAGE(PG8_SA(0, 0), cA, voffA); PG8_STAGE(PG8_SB(0, 1), cB + hstep, voffB); PG8_STAGE(PG8_SA(0, 1), cA + hstep, voffA);
        if (wr == 1) PG8_BAR;
        PG8_WAIT_V(4); PG8_BAR;
        PG8_STAGE(PG8_SB(1, 0), cB + kstep, voffB); PG8_STAGE(PG8_SA(1, 0), cA + kstep, voffA); PG8_STAGE(PG8_SB(1, 1), cB + hstep + kstep, voffB);
        PG8_WAIT_V(6); PG8_BAR;
    }
    for (;;) {
        const bool has_next = S.next(ui + 1, nxt);
        const char* nA = has_next ? (const char*)g.A + (size_t)nxt.pm * tstep : cA; const char* nB = has_next ? (const char*)g.Bt + (size_t)(nxt.pn + (g.bsh >= 0 ? (nxt.pm >> g.bsh) * (g.N / BM) : 0)) * tstep : cB;
        for (int t = 0; t < nt; t += 2) {
            const bool last = (t == nt - 2);
            const char* a1 = cA + (size_t)(t + 1) * kstep;
            const char* a2 = last ? nA : cA + (size_t)(t + 2) * kstep; const char* b2 = last ? nB : cB + (size_t)(t + 2) * kstep;
            const char* a3 = a2 + kstep; const char* b3 = b2 + kstep;
            if (last && has_next) S.a_ready(nxt);
            if constexpr (SP2) {
            PG8_LDB(B0, 0, 0); PG8_LDB(B1, 0, 1); PG8_SCHED; PG8_LDA(At, 0, 0); PG8_STAGE(PG8_SA(1, 1), a1 + hstep, voffA);
            PG8_WAIT_V(8); PG8_WAIT_L(0); PG8_BAR; PG8_MMA(0, 0, At, B0); PG8_MMA(0, 1, At, B1); PG8_BAR; PG8_SCHED;
            PG8_LDA(At, 0, 1); PG8_STAGE(PG8_SB(0, 0), b2, voffB); PG8_STAGE(PG8_SB(0, 1), b2 + hstep, voffB); PG8_STAGE(PG8_SA(0, 0), a2, voffA);
            PG8_WAIT_V(8); PG8_WAIT_L(0); PG8_BAR; PG8_MMA(1, 0, At, B0); PG8_MMA(1, 1, At, B1); PG8_BAR; PG8_SCHED;
            PG8_LDB(B0, 1, 0); PG8_LDB(B1, 1, 1); PG8_SCHED; PG8_LDA(At, 1, 0); PG8_STAGE(PG8_SA(0, 1), a2 + hstep, voffA);
            PG8_WAIT_V(8); PG8_WAIT_L(0); PG8_BAR; PG8_MMA(0, 0, At, B0); PG8_MMA(0, 1, At, B1); PG8_BAR; PG8_SCHED;
            PG8_LDA(At, 1, 1); PG8_STAGE(PG8_SB(1, 0), b3, voffB); PG8_STAGE(PG8_SB(1, 1), b3 + hstep, voffB); PG8_STAGE(PG8_SA(1, 0), a3, voffA);
            PG8_WAIT_V(8); PG8_WAIT_L(0); PG8_BAR; PG8_MMA(1, 0, At, B0); PG8_MMA(1, 1, At, B1); PG8_BAR; PG8_SCHED;
            } else {
            PG8_LDB(B0, 0, 0); PG8_SCHED; PG8_LDA(At, 0, 0); PG8_STAGE(PG8_SA(1, 1), a1 + hstep, voffA);
            PG8_WAIT_L(8); PG8_BAR; PG8_WAIT_L(0); PG8_MMA(0, 0, At, B0); PG8_BAR; PG8_SCHED;
            PG8_LDB(B1, 0, 1); PG8_STAGE(PG8_SB(0, 0), b2, voffB);
            PG8_BAR; PG8_WAIT_L(0); PG8_MMA(0, 1, At, B1); PG8_BAR;
            PG8_LDA(At, 0, 1); PG8_STAGE(PG8_SA(0, 0), a2, voffA);
            PG8_BAR; PG8_WAIT_L(0); PG8_MMA(1, 0, At, B0); PG8_BAR; PG8_SCHED;
            PG8_STAGE(PG8_SB(0, 1), b2 + hstep, voffB);
            PG8_WAIT_V(6); PG8_BAR; PG8_MMA(1, 1, At, B1); PG8_BAR;
            PG8_LDB(B0, 1, 0); PG8_SCHED; PG8_LDA(At, 1, 0); PG8_STAGE(PG8_SA(0, 1), a2 + hstep, voffA);
            PG8_WAIT_L(8); PG8_BAR; PG8_WAIT_L(0); PG8_MMA(0, 0, At, B0); PG8_BAR; PG8_SCHED;
            PG8_LDB(B1, 1, 1); PG8_STAGE(PG8_SB(1, 0), b3, voffB);
            PG8_BAR; PG8_WAIT_L(0); PG8_MMA(0, 1, At, B1); PG8_BAR;
            PG8_LDA(At, 1, 1); PG8_STAGE(PG8_SA(1, 0), a3, voffA);
            PG8_BAR; PG8_WAIT_L(0); PG8_MMA(1, 0, At, B0); PG8_BAR; PG8_SCHED;
            PG8_STAGE(PG8_SB(1, 1), b3 + hstep, voffB);
            PG8_WAIT_V(6); PG8_BAR; PG8_MMA(1, 1, At, B1); PG8_BAR;
            }
        }
        if constexpr (ALIGN_EPI) { if (wr == 0) PG8_BAR; }
        if constexpr (I8) {
#pragma unroll
            for (int a = 0; a < 2; ++a)
#pragma unroll
                for (int b = 0; b < 2; ++b)
#pragma unroll
                    for (int m = 0; m < 4; ++m)
#pragma unroll
                        for (int n = 0; n < 2; ++n) acc[a][b][m][n] = __builtin_convertvector(__builtin_bit_cast(i32x4, acc[a][b][m][n]), f32x4); }
        if constexpr (!Epi::AFTER_DRAIN) { E(acc, cur, wr, wc, fr, fq); S.done(cur); }
        if (!has_next) break;
#pragma unroll
        for (int a = 0; a < 2; ++a)
#pragma unroll
            for (int b = 0; b < 2; ++b)
#pragma unroll
                for (int m = 0; m < 4; ++m)
#pragma unroll
                    for (int n = 0; n < 2; ++n) acc[a][b][m][n] = (f32x4){0.f, 0.f, 0.f, 0.f};
        cur = nxt; cA = nA; cB = nB; ++ui;
        if constexpr (ALIGN_EPI) { if (wr == 1) PG8_BAR; }
    }
    PG8_WAIT_V(0);
    if constexpr (!ALIGN_EPI) { if (wr == 0) PG8_BAR; }
    PG8_BAR;
    if constexpr (Epi::AFTER_DRAIN) { E.fused(acc, cur, wr, wc, fr, fq, lds, wid, lane); S.done(cur); }
#undef PG8_SA
#undef PG8_SB
#undef PG8_STAGE
#undef PG8_LDA
#undef PG8_LDB
#undef PG8_MMA
#undef PG8_WAIT_V
#undef PG8_WAIT_L
#undef PG8_BAR
#undef PG8_SCHED
}
}


constexpr int NB = 4, SEQ = 8192, DM = 1024, T = NB * SEQ;
constexpr int NPROJ = 3072, HW = 512, HD = 128, HCH = 64;
constexpr int PH = 8, NQ = 2048;
constexpr float EPS = 1e-6f;
constexpr int NWAVES = 8;
#ifndef G1_I8
#define G1_I8 1
#endif
#ifndef G3_I8
#define G3_I8 0
#endif
static_assert(G3_I8 == 0, "the folded second rmsnorm (query GEMM on x1 with per-batch folded weights) is written for the bf16 query GEMM");
#ifndef P10_U4
#define P10_U4 1
#endif
#ifndef P10_V4
#define P10_V4 1
#endif
static_assert(P10_U4 == P10_V4, "the record layouts below are all-8-bit or all-4-bit");
constexpr int P10_UB = P10_U4 ? 512 : 1024, P10_REC = P10_U4 ? 1152 : 2048;
#ifndef MK_PER_PHASE
#define MK_PER_PHASE 0
#endif
constexpr int NPHASE = 11;

constexpr size_t MiB = 1u << 20;
constexpr size_t WS_CTL = 0, CTL_ZERO_BYTES = 1 * MiB;
constexpr size_t WS_MODP = 1 * MiB;
constexpr size_t WS_MOD = 1 * MiB + 800 * 1024;
constexpr size_t WS_LB = 1 * MiB + 900 * 1024;
constexpr size_t WS_SW = 1 * MiB + 910 * 1024;
constexpr size_t WS_SA = 498 * MiB;
constexpr int CW_COLMAX = 65536;
constexpr size_t WS_WIN = 2 * MiB, WS_WOUT = 8 * MiB, WS_WQ = 10 * MiB, WS_KEYS = 14 * MiB, WS_SPW = 15 * MiB;
constexpr size_t WS_UT = 16 * MiB, WS_VT = 32 * MiB;
constexpr size_t WS_USC = 48 * MiB, WS_VSC = 48 * MiB + 65536;
constexpr size_t WS_QBIAS = 52 * MiB;
constexpr size_t WS_GM = 52 * MiB + 65536;
constexpr size_t WS_SSQ = 53 * MiB;
constexpr size_t WS_WQF = 56 * MiB;
constexpr size_t WS_XN = 80 * MiB;
constexpr size_t WS_PROJ = 144 * MiB;
constexpr size_t WS_STATE = 336 * MiB;
constexpr size_t WS_X1 = 272 * MiB;
constexpr size_t WS_DEC = 400 * MiB;
constexpr size_t WS_CAT = 402 * MiB;
constexpr size_t WS_IDX = 466 * MiB, WS_GATE = 482 * MiB;
constexpr size_t WS_END = 499 * MiB;
constexpr int CW_BAR = 4096;

constexpr int RING_BYTES = 131072;
constexpr int LDSCTL_OFF = RING_BYTES, MISC_OFF = LDSCTL_OFF + 320;
constexpr int LDS_BYTES = 147456;
constexpr int LDS_SPARE = 135168;

#define GAS __attribute__((address_space(1)))
#define LAS __attribute__((address_space(3)))
typedef unsigned short bf16;
typedef unsigned v4u __attribute__((ext_vector_type(4)));
typedef unsigned v2u __attribute__((ext_vector_type(2)));
typedef float f32x4 __attribute__((ext_vector_type(4)));
typedef float f32x16 __attribute__((ext_vector_type(16)));
typedef float f32x2 __attribute__((ext_vector_type(2)));
typedef int i32x4 __attribute__((ext_vector_type(4)));
typedef short bf16x8 __attribute__((ext_vector_type(8)));
typedef GAS unsigned gu32;
#define LDS_WAIT() asm volatile("s_waitcnt lgkmcnt(0)" ::: "memory")
#define VM_WAIT() asm volatile("s_waitcnt vmcnt(0)" ::: "memory")
__device__ __forceinline__ unsigned pk2(float lo, float hi) { unsigned r; asm("v_cvt_pk_bf16_f32 %0, %1, %2" : "=v"(r) : "v"(lo), "v"(hi)); return r; }
__device__ __forceinline__ unsigned f2bf(float f) { return pk2(f, 0.f) & 0xffffu; }
__device__ __forceinline__ unsigned f2bf_sw(float f) { unsigned u = __builtin_bit_cast(unsigned, f); return (u + 0x7fffu + ((u >> 16) & 1u)) >> 16; }
__device__ __forceinline__ unsigned pk2_sw(float lo, float hi) { return f2bf_sw(lo) | (f2bf_sw(hi) << 16); }
__device__ __forceinline__ float bf2f(unsigned short h) { return __uint_as_float((unsigned)h << 16); }
__device__ __forceinline__ float bflo(unsigned w) { return __uint_as_float(w << 16); }
__device__ __forceinline__ float bfhi(unsigned w) { return __uint_as_float(w & 0xffff0000u); }
__device__ __forceinline__ float rcp_f(float x) { return __builtin_amdgcn_rcpf(x); }
__device__ __forceinline__ float rsq_f(float x) { return __builtin_amdgcn_rsqf(x); }
__device__ __forceinline__ float silu_f(float x) { return x * rcp_f(1.f + __expf(-x)); }
__device__ __forceinline__ float gelu_div(float x) { const float z = 0.7978845608f * (x + 0.044715f * x * x * x); const float e = __expf(2.f * z); return x * (1.f - 1.f / (1.f + e)); }
__device__ __forceinline__ float gelu_fast(float x) { const float e = __builtin_amdgcn_exp2f(2.3022082f * (x + 0.044715f * x * x * x)); return x * (1.f - __builtin_amdgcn_rcpf(1.f + e)); }
__device__ __forceinline__ float gelu_f(float x) { const float z = 0.7978845608f * (x + 0.044715f * x * x * x); const float e = __expf(2.f * z); return x * (1.f - rcp_f(1.f + e)); }

#define XB_TMO      128
#define XB_XCNT(j)  (256  + 64 * (j))
#define XB_XSUB(j)  (1280 + 64 * (j))
#define XB_XGEN(j)  (2304 + 64 * (j))
#define XB_TOP      3328
#define XB_TOPGEN   3392
#define XCD_BAR_WORDS 3456
#define XB_SPIN_CAP (1u << 18)

__device__ __forceinline__ unsigned xb_ld(unsigned* p)              { return __hip_atomic_load(p, __ATOMIC_RELAXED, __HIP_MEMORY_SCOPE_AGENT); }
__device__ __forceinline__ unsigned xb_add(unsigned* p, unsigned v) { return __hip_atomic_fetch_add(p, v, __ATOMIC_RELAXED, __HIP_MEMORY_SCOPE_AGENT); }
__device__ __forceinline__ unsigned xb_xcc_id() { return (unsigned)__builtin_amdgcn_s_getreg((3 << 11) | 20) & 0xFu; }
#define XB_SPIN(cond, bar) do { unsigned _sp = 0; while (cond) { __builtin_amdgcn_s_sleep(1); \
    if ((++_sp & 255u) == 0u) { if (xb_ld(&(bar)[XB_TMO])) break; if (_sp > XB_SPIN_CAP) { atomicAdd(&(bar)[XB_TMO], 1u); break; } } } } while (0)

struct XcdBarrier {
    unsigned* bar; unsigned x;
    volatile LAS unsigned* st;
};

__device__ __forceinline__ XcdBarrier xcd_barrier_post(unsigned* bar, volatile LAS unsigned* st) {
    XcdBarrier b; b.bar = bar; b.x = xb_xcc_id(); b.st = st;
    if (threadIdx.x == 0) (void)xb_add(&bar[XB_XCNT(b.x)], 1u);
    return b;
}
__device__ __forceinline__ void xcd_barrier_complete(unsigned* bar, unsigned x, unsigned& nloc, unsigned& nx) {
    const unsigned G = gridDim.x * gridDim.y * gridDim.z;
    unsigned sum, cnt, mine, sp = 0u;
    for (;;) {
        sum = 0u; cnt = 0u; mine = 0u;
#pragma unroll
        for (unsigned j = 0; j < 16; ++j) { const unsigned c = xb_ld(&bar[XB_XCNT(j)]); sum += c; cnt += (c > 0u) ? 1u : 0u; mine = (j == x) ? c : mine; }
        if (sum == G) break;
        __builtin_amdgcn_s_sleep(1);
        if ((++sp & 255u) == 0u) { if (xb_ld(&bar[XB_TMO])) break; if (sp > XB_SPIN_CAP) { atomicAdd(&bar[XB_TMO], 1u); break; } }
    }
    nloc = mine > 0u ? mine : 1u; nx = cnt > 0u ? cnt : 1u;
}

__device__ __forceinline__ void xcd_barrier(const XcdBarrier& b) {
    asm volatile("s_waitcnt vmcnt(0)" ::: "memory");
    __syncthreads();
    if (threadIdx.x == 0) {
        unsigned* bar = b.bar;
        __builtin_amdgcn_s_waitcnt(0);
        unsigned nloc = b.st[0], nx = b.st[1];
        if (nloc == 0u) { xcd_barrier_complete(bar, b.x, nloc, nx); b.st[0] = nloc; b.st[1] = nx; }
        const unsigned old = xb_add(&bar[XB_XSUB(b.x)], 1u);
        const unsigned gen = old / nloc;
        if (old + 1u == (gen + 1u) * nloc) {
            __builtin_amdgcn_fence(__ATOMIC_RELEASE, "agent");
            asm volatile("s_waitcnt vmcnt(0)" ::: "memory");
            const unsigned og = xb_add(&bar[XB_TOP], 1u);
            const unsigned tg = og / nx;
            if (og + 1u == (tg + 1u) * nx) xb_add(&bar[XB_TOPGEN], 1u);
            else XB_SPIN(xb_ld(&bar[XB_TOPGEN]) == tg, bar);
            __builtin_amdgcn_fence(__ATOMIC_ACQUIRE, "agent");
            xb_add(&bar[XB_XGEN(b.x)], 1u);
            asm volatile("s_waitcnt vmcnt(0)" ::: "memory");
        } else {
            XB_SPIN(xb_ld(&bar[XB_XGEN(b.x)]) == gen, bar);
            __builtin_amdgcn_fence(__ATOMIC_ACQUIRE, "agent");
            asm volatile("s_waitcnt vmcnt(0)" ::: "memory");
        }
    }
    __syncthreads();
}


struct Frame {
    LAS unsigned char* lds;
    volatile LAS unsigned* MISC;
    gu32* ctl;
    int tid, lane, wave, vcu, G;
    const float *x, *c, *ada_w, *ada_b, *norm1_g, *w_in, *lb_gamma, *hgrn_g, *ln_g, *ln_b, *sp_w, *sp_b, *gm_g, *w_out, *norm2_g, *wq, *keys, *pu, *pv, *final_g;
    float* out;
    float *MODP, *MOD, *LB, *DEC, *GATE, *SW, *SA, *QBIAS, *GM, *SSQ; bf16 *X1, *WQF;
    int* IDX;
    bf16 *WIN, *WOUT, *WQ, *KEYS, *SPW, *XN, *PROJ, *QB, *STATE, *CAT;
    unsigned char *UT, *VT; float *USC, *VSC;
};

__device__ __forceinline__ float wave_sum(float v) {
#pragma unroll
    for (int o = 1; o < 64; o <<= 1) v += __shfl_xor(v, o);
    return v;
}
__device__ __forceinline__ void p0_transpose_item(const float* W, int K, int N, bf16* WT, int row_off, LAS float* scr, int item, int lane) {
    const int nblk = N / 32, kb = item / nblk, nb = item % nblk, k0 = 64 * kb, n0 = 32 * nb;
#pragma unroll
    for (int i = 0; i < 32; ++i) { const int kk = 2 * i + (lane >> 5); scr[kk * 33 + (lane & 31)] = W[(size_t)(k0 + kk) * N + n0 + (lane & 31)]; }
    LDS_WAIT(); asm volatile("" ::: "memory");
    const int c = lane & 7;
#pragma unroll
    for (int j = 0; j < 4; ++j) { const int n = (lane >> 3) + 8 * j; const LAS float* s = scr + (8 * c) * 33 + n;
        v4u o; o.x = pk2(s[0 * 33], s[1 * 33]); o.y = pk2(s[2 * 33], s[3 * 33]); o.z = pk2(s[4 * 33], s[5 * 33]); o.w = pk2(s[6 * 33], s[7 * 33]);
        *(GAS v4u*)(WT + (size_t)(row_off + n0 + n) * K + k0 + 8 * c) = o; }
    LDS_WAIT(); asm volatile("" ::: "memory");
}
__device__ __forceinline__ void p1_fold_item(const float* W, int K, int N, bf16* WT, const LAS float* gm, LAS float* scr, int item, int lane) {
    const int nblk = N / 32, kb = item / nblk, nb = item % nblk, k0 = 64 * kb, n0 = 32 * nb;
#pragma unroll
    for (int i = 0; i < 32; ++i) { const int kk = 2 * i + (lane >> 5); scr[kk * 33 + (lane & 31)] = W[(size_t)(k0 + kk) * N + n0 + (lane & 31)] * gm[k0 + kk]; }
    LDS_WAIT(); asm volatile("" ::: "memory");
    const int c = lane & 7;
#pragma unroll
    for (int j = 0; j < 4; ++j) { const int n = (lane >> 3) + 8 * j; const LAS float* s = scr + (8 * c) * 33 + n;
        v4u o; o.x = pk2(s[0 * 33], s[1 * 33]); o.y = pk2(s[2 * 33], s[3 * 33]); o.z = pk2(s[4 * 33], s[5 * 33]); o.w = pk2(s[6 * 33], s[7 * 33]);
        *(GAS v4u*)(WT + (size_t)(n0 + n) * K + k0 + 8 * c) = o; }
    LDS_WAIT(); asm volatile("" ::: "memory");
}
__device__ __forceinline__ void p0_colmax_item(const float* W, int N, unsigned* colmax, int item, int lane) {
    const int nblk = N / 32, kb = item / nblk, nb = item % nblk, k0 = 64 * kb, n0 = 32 * nb; float m = 0.f;
#pragma unroll
    for (int i = 0; i < 32; ++i) { const int kk = 2 * i + (lane >> 5); m = fmaxf(m, fabsf(W[(size_t)(k0 + kk) * N + n0 + (lane & 31)])); }
    m = fmaxf(m, __shfl_xor(m, 32));
    if (lane < 32) atomicMax(colmax + n0 + lane, __float_as_uint(m));
}
__device__ __forceinline__ void p1_qtranspose_item(const float* W, int K, int N, unsigned char* WT, const unsigned* colmax, float* sw, LAS float* scr, int item, int lane) {
    const int nblk = N / 32, kb = item / nblk, nb = item % nblk, k0 = 64 * kb, n0 = 32 * nb;
#pragma unroll
    for (int i = 0; i < 32; ++i) { const int kk = 2 * i + (lane >> 5); scr[kk * 33 + (lane & 31)] = W[(size_t)(k0 + kk) * N + n0 + (lane & 31)]; }
    LDS_WAIT(); asm volatile("" ::: "memory");
    const int c = lane & 7;
#pragma unroll
    for (int j = 0; j < 4; ++j) { const int n = (lane >> 3) + 8 * j; const LAS float* sp = scr + (8 * c) * 33 + n;
        const float mx = __uint_as_float(__hip_atomic_load(colmax + n0 + n, __ATOMIC_RELAXED, __HIP_MEMORY_SCOPE_AGENT)), inv = mx > 0.f ? 127.f / mx : 0.f;
        unsigned lo = 0u, hi = 0u;
#pragma unroll
        for (int e = 0; e < 4; ++e) { lo |= ((unsigned)(int)rintf(sp[e * 33] * inv) & 0xffu) << (8 * e); hi |= ((unsigned)(int)rintf(sp[(4 + e) * 33] * inv) & 0xffu) << (8 * e); }
        *(GAS v2u*)(WT + (size_t)(n0 + n) * K + k0 + 8 * c) = (v2u){lo, hi};
        if (kb == 0 && c == 0) sw[n0 + n] = mx * (1.f / 127.f); }
    LDS_WAIT(); asm volatile("" ::: "memory");
}
__device__ __forceinline__ void cvt8(const float* src, bf16* dst) {
    const f32x4 a = *(const GAS f32x4*)src, b = *(const GAS f32x4*)(src + 4);
    v4u o; o.x = pk2(a.x, a.y); o.y = pk2(a.z, a.w); o.z = pk2(b.x, b.y); o.w = pk2(b.z, b.w);
    *(GAS v4u*)dst = o;
}

__device__ __forceinline__ void p0_prologue(Frame& F) {
    LAS float* cact = (LAS float*)(F.lds);
    LAS float* red = (LAS float*)(F.lds + 16384);
#pragma unroll
    for (int j = 0; j < 8; ++j) { const int i = F.tid + 512 * j; const float v = F.c[i]; cact[i] = v * rcp_f(1.f + __expf(-v)); }
    __syncthreads();
    for (int it = F.vcu; it < 192; it += F.G) {
        const int cg = it % 24, kg = it / 24, k0 = kg * 128 + F.wave * 16, col = cg * 256 + 4 * F.lane;
        f32x4 w[16];
#pragma unroll
        for (int i = 0; i < 16; ++i) w[i] = *(const GAS f32x4*)(F.ada_w + (size_t)(k0 + i) * 6144 + col);
        f32x4 a[4];
#pragma unroll
        for (int b = 0; b < 4; ++b) a[b] = (f32x4){0.f, 0.f, 0.f, 0.f};
#pragma unroll
        for (int i = 0; i < 16; ++i)
#pragma unroll
            for (int b = 0; b < 4; ++b) a[b] += w[i] * cact[b * 1024 + k0 + i];
#pragma unroll
        for (int b = 0; b < 4; ++b) *(LAS f32x4*)(red + (F.wave * 4 + b) * 256 + 4 * F.lane) = a[b];
        __syncthreads();
        for (int o = F.tid; o < 1024; o += 512) { float s = 0.f;
#pragma unroll
            for (int w8 = 0; w8 < 8; ++w8) s += red[w8 * 1024 + o];
            F.MODP[(size_t)(kg * 4 + (o >> 8)) * 6144 + cg * 256 + (o & 255)] = s; }
        __syncthreads();
    }
    {
        LAS float* scr = (LAS float*)(F.lds + F.wave * 16384);
        const int gw = F.vcu * NWAVES + F.wave, NGW = F.G * NWAVES;
        constexpr int I_IN = (DM / 64) * (NPROJ / 32), I_OUT = (DM / 64) * (DM / 32), I_Q = (DM / 64) * (NQ / 32);
        for (int it = gw; it < I_IN + I_OUT + (G3_I8 ? I_Q : 0); it += NGW) {
            int r = it;
            if (r < I_IN) { p0_colmax_item(F.w_in, NPROJ, (unsigned*)(F.ctl + CW_COLMAX), r, F.lane); continue; } r -= I_IN;
            if (r < I_OUT) { p0_transpose_item(F.w_out, DM, DM, F.WOUT, 0, scr, r, F.lane); continue; } r -= I_OUT;
            p0_colmax_item(F.wq, NQ, (unsigned*)(F.ctl + CW_COLMAX) + NPROJ, r, F.lane);
        }
    }
    const int gt = F.vcu * 512 + F.tid, NT = F.G * 512;
    for (int i = gt; i < (PH * 2 * 128 * 128) / 8; i += NT) cvt8(F.keys + (size_t)i * 8, F.KEYS + (size_t)i * 8);
    for (int i = gt; i < (4 * 128 * 128) / 8; i += NT) { const int s0 = (i & 15) * 8, tt = (i >> 4) & 127;
        const f32x4 a = *(const GAS f32x4*)(F.sp_w + (size_t)i * 8), b = *(const GAS f32x4*)(F.sp_w + (size_t)i * 8 + 4);
        float v[8] = {a.x, a.y, a.z, a.w, b.x, b.y, b.z, b.w};
#pragma unroll
        for (int j = 0; j < 8; ++j) v[j] = (s0 + j <= tt) ? v[j] : 0.f;
        v4u o; o.x = pk2(v[0], v[1]); o.y = pk2(v[2], v[3]); o.z = pk2(v[4], v[5]); o.w = pk2(v[6], v[7]);
        *(GAS v4u*)(F.SPW + (size_t)i * 8) = o; }
    for (int i = gt; i < HW; i += NT) { const float g0 = F.lb_gamma[i], g1 = F.lb_gamma[HW + i]; F.LB[i] = 1.f / (1.f + __expf(g1 - g0)); }
    {
        const int gw = F.vcu * NWAVES + F.wave, NGW = F.G * NWAVES;
        for (int r0 = gw; r0 < 2 * 16384; r0 += 2 * NGW) {
            f32x4 vv[2][4];
#pragma unroll
            for (int k = 0; k < 2; ++k) { const int r = r0 + k * NGW; const bool isv = r >= 16384; const int row = isv ? r - 16384 : r;
                const GAS f32x4* src = (const GAS f32x4*)((isv ? F.pv : F.pu) + (size_t)row * DM) + F.lane;
#pragma unroll
                for (int j = 0; j < 4; ++j) vv[k][j] = src[64 * j]; }
#pragma unroll
            for (int k = 0; k < 2; ++k) { const int r = r0 + k * NGW; const bool isv = r >= 16384; const int row = isv ? r - 16384 : r;
            unsigned char* part = F.UT + (size_t)row * P10_REC + (isv ? P10_UB : 0);
            f32x4 v[4];
#pragma unroll
            for (int j = 0; j < 4; ++j) v[j] = vv[k][j];
            if (isv ? (P10_V4 != 0) : (P10_U4 != 0)) {
                const int off = isv ? 8 : 0;
#pragma unroll
                for (int j = 0; j < 4; ++j) {
                    float mp = fmaxf(fmaxf(v[j].x, v[j].y), fmaxf(v[j].z, v[j].w)), mn = fmaxf(fmaxf(-v[j].x, -v[j].y), fmaxf(-v[j].z, -v[j].w));
                    mp = fmaxf(mp, __shfl_xor(mp, 1)); mp = fmaxf(mp, __shfl_xor(mp, 2)); mp = fmaxf(mp, __shfl_xor(mp, 4));
                    mn = fmaxf(mn, __shfl_xor(mn, 1)); mn = fmaxf(mn, __shfl_xor(mn, 2)); mn = fmaxf(mn, __shfl_xor(mn, 4));
                    const float ssgn = mp >= mn ? -mp * 0.125f : mn * 0.125f;
                    const unsigned ab = f2bf(fabsf(ssgn)); const unsigned sb = ab | (ssgn < 0.f ? 0x8000u : 0u); const float sc = __uint_as_float(sb << 16), inv = ab != 0u ? 1.f / sc : 0.f;
                    const float xs[4] = {v[j].x, v[j].y, v[j].z, v[j].w}; unsigned pk = 0u;
#pragma unroll
                    for (int e = 0; e < 4; ++e) { int q = (int)rintf(xs[e] * inv); q = q < -8 ? -8 : (q > 7 ? 7 : q); pk |= ((unsigned)(q + off) & 15u) << (4 * e); }
                    *(GAS unsigned short*)(part + 128 * j + 2 * F.lane) = (unsigned short)pk;
                    if ((F.lane & 7) == 0) { const int g = 8 * j + (F.lane >> 3); *(GAS unsigned short*)(F.UT + (size_t)row * P10_REC + 1024 + 8 * (g & 15) + (isv ? 4 : 0) + 2 * (g >> 4)) = (unsigned short)sb; } }
            } else {
                float mx = 0.f;
#pragma unroll
                for (int j = 0; j < 4; ++j) mx = fmaxf(mx, fmaxf(fmaxf(fabsf(v[j].x), fabsf(v[j].y)), fmaxf(fabsf(v[j].z), fabsf(v[j].w))));
#pragma unroll
                for (int o = 1; o < 64; o <<= 1) mx = fmaxf(mx, __shfl_xor(mx, o));
                const float inv = mx > 0.f ? 127.f / mx : 0.f; const int off = isv ? 128 : 0;
                GAS unsigned* dst = (GAS unsigned*)part + F.lane;
#pragma unroll
                for (int j = 0; j < 4; ++j) { const unsigned b0 = (unsigned)((int)rintf(v[j].x * inv) + off) & 0xffu, b1 = (unsigned)((int)rintf(v[j].y * inv) + off) & 0xffu, b2 = (unsigned)((int)rintf(v[j].z * inv) + off) & 0xffu, b3 = (unsigned)((int)rintf(v[j].w * inv) + off) & 0xffu;
                    dst[64 * j] = b0 | (b1 << 8) | (b2 << 16) | (b3 << 24); }
                if (F.lane == 0) (isv ? F.VSC : F.USC)[row] = mx * (1.f / 127.f); } } }
    }
}

__device__ __forceinline__ void norm_row_to_bf16(const float* xrow, bf16* orow, const f32x4 (&gs)[4], const f32x4 (&sh)[4], int lane) {
    const GAS f32x4* xr = (const GAS f32x4*)xrow + lane;
    f32x4 v[4]; float s2 = 0.f;
#pragma unroll
    for (int j = 0; j < 4; ++j) { v[j] = xr[64 * j]; s2 += (v[j].x * v[j].x + v[j].y * v[j].y) + (v[j].z * v[j].z + v[j].w * v[j].w); }
    const float rstd = rsq_f(wave_sum(s2) * (1.f / DM) + EPS);
    GAS v2u* o8 = (GAS v2u*)orow + lane;
#pragma unroll
    for (int j = 0; j < 4; ++j) { const f32x4 y = v[j] * rstd * gs[j] + sh[j]; v2u o; o.x = pk2(y.x, y.y); o.y = pk2(y.z, y.w); o8[64 * j] = o; }
}

__device__ __forceinline__ void norm_bf16row_to_bf16(const bf16* xrow, bf16* orow, const f32x4 (&gs)[4], const f32x4 (&sh)[4], int lane) {
    const GAS v2u* xr = (const GAS v2u*)xrow + lane;
    f32x4 v[4]; float s2 = 0.f;
#pragma unroll
    for (int j = 0; j < 4; ++j) { const v2u w = xr[64 * j]; v[j] = (f32x4){bflo(w.x), bfhi(w.x), bflo(w.y), bfhi(w.y)}; s2 += (v[j].x * v[j].x + v[j].y * v[j].y) + (v[j].z * v[j].z + v[j].w * v[j].w); }
    const float rstd = rsq_f(wave_sum(s2) * (1.f / DM) + EPS);
    GAS v2u* o8 = (GAS v2u*)orow + lane;
#pragma unroll
    for (int j = 0; j < 4; ++j) { const f32x4 y = v[j] * rstd * gs[j] + sh[j]; v2u o; o.x = pk2(y.x, y.y); o.y = pk2(y.z, y.w); o8[64 * j] = o; }
}

__device__ __forceinline__ void norm_rows4_f32(const float* x0, bf16* o0, const f32x4 (&gs)[4], const f32x4 (&sh)[4], int lane) {
    f32x4 v[4][4];
#pragma unroll
    for (int r = 0; r < 4; ++r)
#pragma unroll
        for (int j = 0; j < 4; ++j) v[r][j] = ((const GAS f32x4*)(x0 + (size_t)r * DM) + lane)[64 * j];
#pragma unroll
    for (int r = 0; r < 4; ++r) { float s2 = 0.f;
#pragma unroll
        for (int j = 0; j < 4; ++j) s2 += (v[r][j].x * v[r][j].x + v[r][j].y * v[r][j].y) + (v[r][j].z * v[r][j].z + v[r][j].w * v[r][j].w);
        const float rstd = rsq_f(wave_sum(s2) * (1.f / DM) + EPS); GAS v2u* o8 = (GAS v2u*)(o0 + (size_t)r * DM) + lane;
#pragma unroll
        for (int j = 0; j < 4; ++j) { const f32x4 y = v[r][j] * rstd * gs[j] + sh[j]; v2u o; o.x = pk2(y.x, y.y); o.y = pk2(y.z, y.w); o8[64 * j] = o; } }
}
__device__ __forceinline__ void norm_rows4_bf16(const bf16* x0, bf16* o0, const f32x4 (&gs)[4], const f32x4 (&sh)[4], int lane) {
    v2u w[4][4];
#pragma unroll
    for (int r = 0; r < 4; ++r)
#pragma unroll
        for (int j = 0; j < 4; ++j) w[r][j] = ((const GAS v2u*)(x0 + (size_t)r * DM) + lane)[64 * j];
#pragma unroll
    for (int r = 0; r < 4; ++r) { f32x4 v[4]; float s2 = 0.f;
#pragma unroll
        for (int j = 0; j < 4; ++j) { v[j] = (f32x4){bflo(w[r][j].x), bfhi(w[r][j].x), bflo(w[r][j].y), bfhi(w[r][j].y)}; s2 += (v[j].x * v[j].x + v[j].y * v[j].y) + (v[j].z * v[j].z + v[j].w * v[j].w); }
        const float rstd = rsq_f(wave_sum(s2) * (1.f / DM) + EPS); GAS v2u* o8 = (GAS v2u*)(o0 + (size_t)r * DM) + lane;
#pragma unroll
        for (int j = 0; j < 4; ++j) { const f32x4 y = v[j] * rstd * gs[j] + sh[j]; v2u o; o.x = pk2(y.x, y.y); o.y = pk2(y.z, y.w); o8[64 * j] = o; } }
}

__device__ __forceinline__ void norm_store_i8(const f32x4 (&v)[4], float rstd, const f32x4 (&gs)[4], const f32x4 (&sh)[4], unsigned char* orow, float* sa, int lane) {
    f32x4 y[4]; float mx = 0.f;
#pragma unroll
    for (int j = 0; j < 4; ++j) { y[j] = v[j] * rstd * gs[j] + sh[j]; mx = fmaxf(mx, fmaxf(fmaxf(fabsf(y[j].x), fabsf(y[j].y)), fmaxf(fabsf(y[j].z), fabsf(y[j].w)))); }
#pragma unroll
    for (int o = 1; o < 64; o <<= 1) mx = fmaxf(mx, __shfl_xor(mx, o));
    const float inv = mx > 0.f ? 119.f / mx : 0.f; GAS unsigned* o4 = (GAS unsigned*)orow + lane;
#pragma unroll
    for (int j = 0; j < 4; ++j) o4[64 * j] = ((unsigned)(int)rintf(y[j].x * inv) & 0xffu) | (((unsigned)(int)rintf(y[j].y * inv) & 0xffu) << 8) | (((unsigned)(int)rintf(y[j].z * inv) & 0xffu) << 16) | (((unsigned)(int)rintf(y[j].w * inv) & 0xffu) << 24);
    if (lane == 0) *sa = mx * (1.f / 119.f);
}
__device__ __forceinline__ void norm_rows4_f32_i8(const float* x0, unsigned char* o0, float* sa0, const f32x4 (&gs)[4], const f32x4 (&sh)[4], int lane) {
    f32x4 v[4][4];
#pragma unroll
    for (int r = 0; r < 4; ++r)
#pragma unroll
        for (int j = 0; j < 4; ++j) v[r][j] = ((const GAS f32x4*)(x0 + (size_t)r * DM) + lane)[64 * j];
#pragma unroll
    for (int r = 0; r < 4; ++r) { float s2 = 0.f;
#pragma unroll
        for (int j = 0; j < 4; ++j) s2 += (v[r][j].x * v[r][j].x + v[r][j].y * v[r][j].y) + (v[r][j].z * v[r][j].z + v[r][j].w * v[r][j].w);
        norm_store_i8(v[r], rsq_f(wave_sum(s2) * (1.f / DM) + EPS), gs, sh, o0 + (size_t)r * DM, sa0 + r, lane); }
}
__device__ __forceinline__ void norm_rows4_bf16_i8(const bf16* x0, unsigned char* o0, float* sa0, const f32x4 (&gs)[4], const f32x4 (&sh)[4], int lane) {
    v2u w[4][4];
#pragma unroll
    for (int r = 0; r < 4; ++r)
#pragma unroll
        for (int j = 0; j < 4; ++j) w[r][j] = ((const GAS v2u*)(x0 + (size_t)r * DM) + lane)[64 * j];
#pragma unroll
    for (int r = 0; r < 4; ++r) { f32x4 v[4]; float s2 = 0.f;
#pragma unroll
        for (int j = 0; j < 4; ++j) { v[j] = (f32x4){bflo(w[r][j].x), bfhi(w[r][j].x), bflo(w[r][j].y), bfhi(w[r][j].y)}; s2 += (v[j].x * v[j].x + v[j].y * v[j].y) + (v[j].z * v[j].z + v[j].w * v[j].w); }
        norm_store_i8(v, rsq_f(wave_sum(s2) * (1.f / DM) + EPS), gs, sh, o0 + (size_t)r * DM, sa0 + r, lane); }
}

__device__ __forceinline__ void p1_norm1(Frame& F) {
    LAS float* modl = (LAS float*)(F.lds);
    const int b = F.vcu >> 6;
    {
        float sv[6];
#pragma unroll
        for (int j = 0; j < 6; ++j) { const int n = ((j >> 1) == 2 ? 4096 : (j >> 1) * 1024) + (j & 1) * 512 + F.tid; float s = F.ada_b[n];
#pragma unroll
            for (int kg = 0; kg < 8; ++kg) s += F.MODP[(size_t)(kg * 4 + b) * 6144 + n];
            sv[j] = s; }
#pragma unroll
        for (int j = 0; j < 6; ++j) { const int n = ((j >> 1) == 2 ? 4096 : (j >> 1) * 1024) + (j & 1) * 512 + F.tid; modl[n] = sv[j]; if ((F.vcu & 63) == 0) F.MOD[(size_t)b * 6144 + n] = sv[j]; }
        if ((F.vcu & 63) == 0) {
#pragma unroll
            for (int j = 0; j < 6; ++j) { const int n = ((j >> 1) == 2 ? 5120 : 2048 + (j >> 1) * 1024) + (j & 1) * 512 + F.tid; float s = F.ada_b[n];
#pragma unroll
                for (int kg = 0; kg < 8; ++kg) s += F.MODP[(size_t)(kg * 4 + b) * 6144 + n];
                F.MOD[(size_t)b * 6144 + n] = s; } }
    }
    __syncthreads();
    LAS float* gml = (LAS float*)(F.lds + LDS_SPARE);
    for (int n = F.tid; n < 1024; n += 512) { const float gv = F.norm2_g[n] * (1.f + modl[4096 + n]); gml[n] = gv; if ((F.vcu & 63) == 0) F.GM[(size_t)b * 1024 + n] = gv; }
    f32x4 gs[4], sh[4];
#pragma unroll
    for (int j = 0; j < 4; ++j) { const int c0 = 256 * j + 4 * F.lane; const f32x4 g = *(const GAS f32x4*)(F.norm1_g + c0);
        const f32x4 sc = *(LAS f32x4*)(modl + 1024 + c0); sh[j] = *(LAS f32x4*)(modl + c0); gs[j] = g * (sc + 1.f); }
    const int r0 = F.vcu * 128 + F.wave * 16;
    for (int i = 0; i < 16; i += 4) { if (G1_I8) norm_rows4_f32_i8(F.x + (size_t)(r0 + i) * DM, (unsigned char*)F.XN + (size_t)(r0 + i) * DM, F.SA + r0 + i, gs, sh, F.lane);
        else norm_rows4_f32(F.x + (size_t)(r0 + i) * DM, F.XN + (size_t)(r0 + i) * DM, gs, sh, F.lane); }
    __syncthreads();
    {
        LAS float* scr = (LAS float*)(F.lds + F.wave * 16384);
        const int gw = F.vcu * NWAVES + F.wave, NGW = F.G * NWAVES;
        constexpr int I_IN = (DM / 64) * (NPROJ / 32), I_Q = (DM / 64) * (NQ / 32);
        for (int it = gw; it < I_IN; it += NGW) { if (G1_I8) p1_qtranspose_item(F.w_in, DM, NPROJ, (unsigned char*)F.WIN, (const unsigned*)(F.ctl + CW_COLMAX), F.SW, scr, it, F.lane); else p0_transpose_item(F.w_in, DM, NPROJ, F.WIN, 0, scr, it, F.lane); }
        for (int it = (F.vcu & 63) * NWAVES + F.wave; it < I_Q; it += 64 * NWAVES) p1_fold_item(F.wq, DM, NQ, F.WQF + (size_t)b * NQ * DM, gml, scr, it, F.lane);
    }
    __syncthreads();
}
__device__ __forceinline__ void p7_norm2(Frame& F) {
    const int b = F.vcu >> 6; const float* mod = F.MOD + (size_t)b * 6144;
    f32x4 gs[4], sh[4];
#pragma unroll
    for (int j = 0; j < 4; ++j) { const int c0 = 256 * j + 4 * F.lane; const f32x4 g = *(const GAS f32x4*)(F.norm2_g + c0);
        const f32x4 sc = *(const GAS f32x4*)(mod + 4096 + c0); sh[j] = *(const GAS f32x4*)(mod + 3072 + c0); gs[j] = g * (sc + 1.f); }
    const int r0 = F.vcu * 128 + F.wave * 16;
    for (int i = 0; i < 16; i += 4) { if (G3_I8) norm_rows4_bf16_i8(F.X1 + (size_t)(r0 + i) * DM, (unsigned char*)F.XN + (size_t)(r0 + i) * DM, F.SA + r0 + i, gs, sh, F.lane);
        else norm_rows4_bf16(F.X1 + (size_t)(r0 + i) * DM, F.XN + (size_t)(r0 + i) * DM, gs, sh, F.lane); }
}

#define MFMA16(a, b, c) __builtin_amdgcn_mfma_f32_16x16x32_bf16((a), (b), (c), 0, 0, 0)
#define MFMA32(a, b, c) __builtin_amdgcn_mfma_f32_32x32x16_bf16((a), (b), (c), 0, 0, 0)

struct HRawA { unsigned short z[16], v[16]; };
__device__ __forceinline__ void hgrnA_load(Frame& F, int u, HRawA& r) {
    const int bh = u >> 7, c = u & 127, b = bh >> 2, h = bh & 3, t0 = b * SEQ + c * HCH;
    const int col = F.tid & 127, rg = F.tid >> 7;
    const bf16* pz = F.PROJ + (size_t)(t0 + rg * 16) * NPROJ + HW + h * HD + col;
    const bf16* pv = pz + HW;
#pragma unroll
    for (int i = 0; i < 16; ++i) { r.z[i] = pz[(size_t)i * NPROJ]; r.v[i] = pv[(size_t)i * NPROJ]; }
}
__device__ __forceinline__ void hgrnA_unit(Frame& F, int u, const HRawA& r) {
    const int bh = u >> 7, c = u & 127, b = bh >> 2, h = bh & 3, t0 = b * SEQ + c * HCH; (void)t0; (void)c; (void)b;
    const int col = F.tid & 127, rg = F.tid >> 7;
    LAS unsigned short* KT = (LAS unsigned short*)(F.lds);
    LAS unsigned short* VT = (LAS unsigned short*)(F.lds + 18432);
    LAS float* TOT = (LAS float*)(F.lds + 36864);
    const float lbv = F.LB[h * HD + col], oml = 1.f - lbv;
    float lg[16], kk[16]; unsigned vv[16]; float run = 0.f;
#pragma unroll
    for (int i = 0; i < 16; ++i) { const float z = bf2f(r.z[i]); const float e = __expf(-z), s = rcp_f(1.f + e);
        run += __logf(lbv + oml * s); lg[i] = run; kk[i] = oml * e * s; vv[i] = r.v[i]; }
    TOT[rg * 128 + col] = run;
    __syncthreads();
    float pre = 0.f, tot = 0.f;
#pragma unroll
    for (int g = 0; g < 4; ++g) { const float tv = TOT[g * 128 + col]; pre += (g < rg) ? tv : 0.f; tot += tv; }
    unsigned kw[8], vw[8];
#pragma unroll
    for (int i = 0; i < 8; ++i) { kw[i] = pk2(kk[2 * i] * __expf(-(pre + lg[2 * i])), kk[2 * i + 1] * __expf(-(pre + lg[2 * i + 1]))); vw[i] = vv[2 * i] | (vv[2 * i + 1] << 16); }
    *(LAS v4u*)(KT + col * 72 + rg * 16) = (v4u){kw[0], kw[1], kw[2], kw[3]}; *(LAS v4u*)(KT + col * 72 + rg * 16 + 8) = (v4u){kw[4], kw[5], kw[6], kw[7]};
    *(LAS v4u*)(VT + col * 72 + rg * 16) = (v4u){vw[0], vw[1], vw[2], vw[3]}; *(LAS v4u*)(VT + col * 72 + rg * 16 + 8) = (v4u){vw[4], vw[5], vw[6], vw[7]};
    if (rg == 0) F.DEC[(size_t)u * 128 + col] = __expf(tot);
    __syncthreads();
    const int fr = F.lane & 15, fq = F.lane >> 4, w = F.wave;
    bf16x8 a[2];
#pragma unroll
    for (int ks = 0; ks < 2; ++ks) a[ks] = *(LAS bf16x8*)(KT + (16 * w + fr) * 72 + ks * 32 + fq * 8);
    bf16* st = F.STATE + (size_t)u * 16384;
#pragma unroll
    for (int n = 0; n < 8; ++n) { f32x4 acc = (f32x4){0.f, 0.f, 0.f, 0.f};
#pragma unroll
        for (int ks = 0; ks < 2; ++ks) { const bf16x8 bb = *(LAS bf16x8*)(VT + (16 * n + fr) * 72 + ks * 32 + fq * 8); acc = MFMA16(a[ks], bb, acc); }
        v2u o; o.x = pk2_sw(acc[0], acc[1]); o.y = pk2_sw(acc[2], acc[3]);
        *(GAS v2u*)(st + (16 * n + fr) * 128 + 16 * w + 4 * fq) = o; }
    __syncthreads();
}

__device__ __forceinline__ void gmlp_unit(Frame& F, int u) {
    const int b = u >> 6, n = u & 63, t0 = b * SEQ + n * 128, t = F.tid >> 2, q = F.tid & 3;
    LAS unsigned short* VnT = (LAS unsigned short*)(F.lds);
    LAS float* Og = (LAS float*)(F.lds + 34816);
    const bf16* prow = F.PROJ + (size_t)(t0 + t) * NPROJ;
    float sum = 0.f, sq = 0.f;
#pragma unroll
    for (int g = 0; g < 4; ++g)
#pragma unroll
        for (int k = 0; k < 4; ++k) { const v4u w = *(const GAS v4u*)(prow + 2560 + g * 128 + (4 * k + q) * 8);
            const unsigned ww[4] = {w.x, w.y, w.z, w.w};
#pragma unroll
            for (int j = 0; j < 4; ++j) { const float lo = gelu_f(bflo(ww[j])), hi = gelu_f(bfhi(ww[j])); sum += lo + hi; sq += lo * lo + hi * hi; } }
    sum += __shfl_xor(sum, 1); sum += __shfl_xor(sum, 2); sq += __shfl_xor(sq, 1); sq += __shfl_xor(sq, 2);
    const float mean = sum * (1.f / 512.f); const float var = fmaxf(sq * (1.f / 512.f) - mean * mean, 0.f);
    const float rstd = rsq_f(var + EPS);
    const int fr = F.lane & 15, fq = F.lane >> 4, w = F.wave;
    for (int g = 0; g < 4; ++g) {
#pragma unroll
        for (int k = 0; k < 4; ++k) { const int lc = (4 * k + q) * 8, ch = g * 128 + lc;
            const v4u wv = *(const GAS v4u*)(prow + 2560 + ch); const unsigned ww[4] = {wv.x, wv.y, wv.z, wv.w};
            const f32x4 lga = *(const GAS f32x4*)(F.ln_g + ch), lgb = *(const GAS f32x4*)(F.ln_g + ch + 4), lba = *(const GAS f32x4*)(F.ln_b + ch), lbb = *(const GAS f32x4*)(F.ln_b + ch + 4);
            const float lgs[8] = {lga.x, lga.y, lga.z, lga.w, lgb.x, lgb.y, lgb.z, lgb.w}, lbs[8] = {lba.x, lba.y, lba.z, lba.w, lbb.x, lbb.y, lbb.z, lbb.w};
#pragma unroll
            for (int j = 0; j < 4; ++j) { const float lo = gelu_f(bflo(ww[j])), hi = gelu_f(bfhi(ww[j]));
                VnT[(lc + 2 * j) * 136 + t] = (unsigned short)f2bf((lo - mean) * rstd * lgs[2 * j] + lbs[2 * j]);
                VnT[(lc + 2 * j + 1) * 136 + t] = (unsigned short)f2bf((hi - mean) * rstd * lgs[2 * j + 1] + lbs[2 * j + 1]); } }
        v4u uw[4];
#pragma unroll
        for (int k = 0; k < 4; ++k) uw[k] = *(const GAS v4u*)(prow + 2048 + g * 128 + (4 * k + q) * 8);
        __syncthreads();
        bf16x8 a[4];
#pragma unroll
        for (int ks = 0; ks < 4; ++ks) a[ks] = *(const GAS bf16x8*)(F.SPW + (size_t)(g * 128 + 16 * w + fr) * 128 + ks * 32 + fq * 8);
        f32x4 sb;
#pragma unroll
        for (int r = 0; r < 4; ++r) sb[r] = F.sp_b[g * 128 + 16 * w + 4 * fq + r];
#pragma unroll
        for (int nn = 0; nn < 8; ++nn) { f32x4 acc = (f32x4){0.f, 0.f, 0.f, 0.f};
#pragma unroll
            for (int ks = 0; ks < 4; ++ks) { const bf16x8 bb = *(LAS bf16x8*)(VnT + (16 * nn + fr) * 136 + ks * 32 + fq * 8); acc = MFMA16(a[ks], bb, acc); }
#pragma unroll
            for (int r = 0; r < 4; ++r) Og[(16 * w + 4 * fq + r) * 132 + 16 * nn + fr] = acc[r] + sb[r]; }
        __syncthreads();
        float gm[32]; float ss = 0.f;
#pragma unroll
        for (int k = 0; k < 4; ++k) { const int lc = (4 * k + q) * 8; const unsigned ww[4] = {uw[k].x, uw[k].y, uw[k].z, uw[k].w};
            const f32x4 ma = *(LAS f32x4*)(Og + t * 132 + lc), mb = *(LAS f32x4*)(Og + t * 132 + lc + 4); const float ms[8] = {ma.x, ma.y, ma.z, ma.w, mb.x, mb.y, mb.z, mb.w};
#pragma unroll
            for (int j = 0; j < 4; ++j) { const float g0 = gelu_f(bflo(ww[j])) * ms[2 * j], g1 = gelu_f(bfhi(ww[j])) * ms[2 * j + 1]; gm[k * 8 + 2 * j] = g0; gm[k * 8 + 2 * j + 1] = g1; ss += g0 * g0 + g1 * g1; } }
        ss += __shfl_xor(ss, 1); ss += __shfl_xor(ss, 2);
        const float rs = rsq_f(ss * (1.f / 128.f) + EPS);
#pragma unroll
        for (int k = 0; k < 4; ++k) { const int lc = (4 * k + q) * 8; v4u o; const f32x4 ga = *(const GAS f32x4*)(F.gm_g + g * 128 + lc), gb = *(const GAS f32x4*)(F.gm_g + g * 128 + lc + 4);
            o.x = pk2(gm[k * 8 + 0] * rs * ga.x, gm[k * 8 + 1] * rs * ga.y); o.y = pk2(gm[k * 8 + 2] * rs * ga.z, gm[k * 8 + 3] * rs * ga.w);
            o.z = pk2(gm[k * 8 + 4] * rs * gb.x, gm[k * 8 + 5] * rs * gb.y); o.w = pk2(gm[k * 8 + 6] * rs * gb.z, gm[k * 8 + 7] * rs * gb.w);
            *(GAS v4u*)(F.CAT + (size_t)(t0 + t) * DM + 512 + g * 128 + lc) = o; }
    }
    __syncthreads();
}

__device__ __forceinline__ void p4_qbias(Frame& F) {
    LAS float* red = (LAS float*)(F.lds + LDS_SPARE);
    const int ks = F.tid >> 3, c = F.tid & 7, n = F.vcu * 8 + c; float a[4] = {0.f, 0.f, 0.f, 0.f};
#pragma unroll
    for (int kk = 0; kk < 16; ++kk) { const int k = ks * 16 + kk; const float w = F.wq[(size_t)k * NQ + n];
#pragma unroll
        for (int b = 0; b < 4; ++b) a[b] += F.MOD[(size_t)b * 6144 + 3072 + k] * w; }
#pragma unroll
    for (int b = 0; b < 4; ++b) red[ks * 32 + b * 8 + c] = a[b];
    __syncthreads();
    if (F.tid < 32) { float s = 0.f;
        for (int j = 0; j < 64; ++j) s += red[j * 32 + F.tid];
        F.QBIAS[(size_t)(F.tid >> 3) * NQ + F.vcu * 8 + (F.tid & 7)] = s; }
}
__device__ __forceinline__ void p4_scan(Frame& F) {
    const int bh = F.vcu >> 4, e = ((F.vcu & 15) * 512 + F.tid) * 2, dk = e & 127;
    const bf16* st = F.STATE + (size_t)bh * 128 * 16384 + e; bf16* so = F.XN + (size_t)bh * 128 * 16384 + e; const float* dc = F.DEC + (size_t)bh * 128 * 128 + dk;
    float s0 = 0.f, s1 = 0.f;
    for (int c0 = 0; c0 < 128; c0 += 32) {
        unsigned l[32]; float d0[32], d1[32];
#pragma unroll
        for (int i = 0; i < 32; ++i) { l[i] = *(const GAS unsigned*)(st + (size_t)(c0 + i) * 16384); const f32x2 dd = *(const GAS f32x2*)(dc + (size_t)(c0 + i) * 128); d0[i] = dd.x; d1[i] = dd.y; }
#pragma unroll
        for (int i = 0; i < 32; ++i) { *(GAS unsigned*)(so + (size_t)(c0 + i) * 16384) = pk2(s0, s1); s0 = d0[i] * (s0 + bflo(l[i])); s1 = d1[i] * (s1 + bfhi(l[i])); }
    }
}

struct HRawC { unsigned z[16], v[16], q[16]; };
__device__ __forceinline__ void hgrnC_load(Frame& F, int u, HRawC& R) {
    const int bh = u >> 7, c = u & 127, b = bh >> 2, h = bh & 3, t0 = b * SEQ + c * HCH, col = F.tid & 127, rg = F.tid >> 7;
    const bf16* pq = F.PROJ + (size_t)(t0 + rg * 16) * NPROJ + h * HD + col;
#pragma unroll
    for (int i = 0; i < 16; ++i) { R.z[i] = pq[(size_t)i * NPROJ + HW]; R.v[i] = pq[(size_t)i * NPROJ + 2 * HW]; R.q[i] = pq[(size_t)i * NPROJ]; }
}
__device__ __forceinline__ void hgrnC_unit(Frame& F, int u, const HRawC& R) {
    const int bh = u >> 7, c = u & 127, b = bh >> 2, h = bh & 3, t0 = b * SEQ + c * HCH;
    const int col = F.tid & 127, rg = F.tid >> 7;
    LAS unsigned short* Qs = (LAS unsigned short*)(F.lds);
    LAS unsigned short* Ks = (LAS unsigned short*)(F.lds + 17408);
    LAS unsigned short* VT = (LAS unsigned short*)(F.lds + 34816);
    LAS unsigned short* Ps = (LAS unsigned short*)(F.lds + 53248);
    LAS float* TOT = (LAS float*)(F.lds + 62464);
    LAS float* Os = (LAS float*)(F.lds + 64512);
    const float lbv = F.LB[h * HD + col], oml = 1.f - lbv;
    float lg[16], kk[16], qq[16]; unsigned vv[16]; float run = 0.f;
#pragma unroll
    for (int i = 0; i < 16; ++i) { const float z = bf2f((unsigned short)R.z[i]); const float e = __expf(-z), s = rcp_f(1.f + e);
        run += __logf(lbv + oml * s); lg[i] = run; kk[i] = oml * e * s; vv[i] = R.v[i]; qq[i] = silu_f(bf2f((unsigned short)R.q[i])); }
    TOT[rg * 128 + col] = run;
    __syncthreads();
    float pre = 0.f;
#pragma unroll
    for (int g = 0; g < 4; ++g) { const float tv = TOT[g * 128 + col]; pre += (g < rg) ? tv : 0.f; }
    unsigned vw[8];
#pragma unroll
    for (int i = 0; i < 16; ++i) { const float bb = pre + lg[i]; Qs[(rg * 16 + i) * 136 + col] = (unsigned short)f2bf(qq[i] * __expf(bb)); Ks[(rg * 16 + i) * 136 + col] = (unsigned short)f2bf(kk[i] * __expf(-bb)); }
#pragma unroll
    for (int i = 0; i < 8; ++i) vw[i] = vv[2 * i] | (vv[2 * i + 1] << 16);
    *(LAS v4u*)(VT + col * 72 + rg * 16) = (v4u){vw[0], vw[1], vw[2], vw[3]}; *(LAS v4u*)(VT + col * 72 + rg * 16 + 8) = (v4u){vw[4], vw[5], vw[6], vw[7]};
    __syncthreads();
    const int fr = F.lane & 15, fq = F.lane >> 4, w = F.wave;
    {
        const int tt = w >> 1;
#pragma unroll
        for (int j = 0; j < 2; ++j) { const int st = (w & 1) * 2 + j; f32x4 acc = (f32x4){0.f, 0.f, 0.f, 0.f};
            if (st <= tt) {
#pragma unroll
                for (int ks = 0; ks < 4; ++ks) { const bf16x8 aa = *(LAS bf16x8*)(Qs + (16 * tt + fr) * 136 + ks * 32 + fq * 8); const bf16x8 bb = *(LAS bf16x8*)(Ks + (16 * st + fr) * 136 + ks * 32 + fq * 8); acc = MFMA16(aa, bb, acc); } }
#pragma unroll
            for (int r = 0; r < 4; ++r) { const int tr = 16 * tt + 4 * fq + r, sc = 16 * st + fr; Ps[tr * 72 + sc] = (unsigned short)f2bf_sw(sc <= tr ? acc[r] : 0.f); } }
    }
    __syncthreads();
    {
        bf16x8 bi[2], bs[4]; const bf16* st = F.XN + (size_t)u * 16384 + (size_t)(16 * w + fr) * 128 + fq * 8;
#pragma unroll
        for (int ks = 0; ks < 2; ++ks) bi[ks] = *(LAS bf16x8*)(VT + (16 * w + fr) * 72 + ks * 32 + fq * 8);
#pragma unroll
        for (int ks = 0; ks < 4; ++ks) bs[ks] = *(const GAS bf16x8*)(st + ks * 32);
#pragma unroll
        for (int tt = 0; tt < 4; ++tt) { f32x4 acc = (f32x4){0.f, 0.f, 0.f, 0.f};
#pragma unroll
            for (int ks = 0; ks < 2; ++ks) { const bf16x8 aa = *(LAS bf16x8*)(Ps + (16 * tt + fr) * 72 + ks * 32 + fq * 8); acc = MFMA16(aa, bi[ks], acc); }
#pragma unroll
            for (int ks = 0; ks < 4; ++ks) { const bf16x8 aa = *(LAS bf16x8*)(Qs + (16 * tt + fr) * 136 + ks * 32 + fq * 8); acc = MFMA16(aa, bs[ks], acc); }
#pragma unroll
            for (int r = 0; r < 4; ++r) Os[(16 * tt + 4 * fq + r) * 132 + 16 * w + fr] = acc[r]; }
    }
    __syncthreads();
    {
        const int row = F.tid >> 3, cs = (F.tid & 7) * 16; float o[16]; float ss = 0.f;
#pragma unroll
        for (int k = 0; k < 4; ++k) { const f32x4 v = *(LAS f32x4*)(Os + row * 132 + cs + 4 * k); o[4 * k] = v.x; o[4 * k + 1] = v.y; o[4 * k + 2] = v.z; o[4 * k + 3] = v.w; ss += (v.x * v.x + v.y * v.y) + (v.z * v.z + v.w * v.w); }
        ss += __shfl_xor(ss, 1); ss += __shfl_xor(ss, 2); ss += __shfl_xor(ss, 4);
        const float rs = rsq_f(ss * (1.f / 128.f) + EPS);
        const bf16* pog = F.PROJ + (size_t)(t0 + row) * NPROJ + 3 * HW + h * HD + cs; const float* gg = F.hgrn_g + h * HD + cs;
        bf16* orow = F.CAT + (size_t)(t0 + row) * DM + h * HD + cs;
#pragma unroll
        for (int k = 0; k < 2; ++k) { const v4u gw = *(const GAS v4u*)(pog + 8 * k); const unsigned ww[4] = {gw.x, gw.y, gw.z, gw.w}; unsigned ow[4];
#pragma unroll
            for (int j = 0; j < 4; ++j) { const int i0 = 8 * k + 2 * j; ow[j] = pk2(o[i0] * rs * gg[i0] * silu_f(bflo(ww[j])), o[i0 + 1] * rs * gg[i0 + 1] * silu_f(bfhi(ww[j]))); }
            *(GAS v4u*)(orow + 8 * k) = (v4u){ow[0], ow[1], ow[2], ow[3]}; }
    }
    __syncthreads();
}

__device__ __forceinline__ unsigned f2sort(float f) { const unsigned u = __float_as_uint(f); return (u & 0x80000000u) ? ~u : (u | 0x80000000u); }
__device__ __forceinline__ float sort2f(unsigned s) { const unsigned u = (s & 0x80000000u) ? (s & 0x7fffffffu) : ~s; return __uint_as_float(u); }
__device__ __forceinline__ void insert16(unsigned (&L)[16], unsigned x) {
#pragma unroll
    for (int i = 0; i < 16; ++i) { const unsigned hi = L[i] > x ? L[i] : x; x = L[i] > x ? x : L[i]; L[i] = hi; }
}
__device__ __forceinline__ void ce_desc(unsigned& a, unsigned& b) { const unsigned mx = a > b ? a : b, mn = a > b ? b : a; a = mx; b = mn; }
__device__ __forceinline__ void sort16_desc(unsigned (&x)[16]) {
    ce_desc(x[0], x[13]); ce_desc(x[1], x[12]); ce_desc(x[2], x[15]); ce_desc(x[3], x[14]); ce_desc(x[4], x[8]); ce_desc(x[5], x[6]); ce_desc(x[7], x[11]); ce_desc(x[9], x[10]);
    ce_desc(x[0], x[5]); ce_desc(x[1], x[7]); ce_desc(x[2], x[9]); ce_desc(x[3], x[4]); ce_desc(x[6], x[13]); ce_desc(x[8], x[14]); ce_desc(x[10], x[15]); ce_desc(x[11], x[12]);
    ce_desc(x[0], x[1]); ce_desc(x[2], x[3]); ce_desc(x[4], x[5]); ce_desc(x[6], x[8]); ce_desc(x[7], x[9]); ce_desc(x[10], x[11]); ce_desc(x[12], x[13]); ce_desc(x[14], x[15]);
    ce_desc(x[0], x[2]); ce_desc(x[1], x[3]); ce_desc(x[4], x[10]); ce_desc(x[5], x[11]); ce_desc(x[6], x[7]); ce_desc(x[8], x[9]); ce_desc(x[12], x[14]); ce_desc(x[13], x[15]);
    ce_desc(x[1], x[2]); ce_desc(x[3], x[12]); ce_desc(x[4], x[6]); ce_desc(x[5], x[7]); ce_desc(x[8], x[10]); ce_desc(x[9], x[11]); ce_desc(x[13], x[14]);
    ce_desc(x[1], x[4]); ce_desc(x[2], x[6]); ce_desc(x[5], x[8]); ce_desc(x[7], x[10]); ce_desc(x[9], x[13]); ce_desc(x[11], x[14]);
    ce_desc(x[2], x[4]); ce_desc(x[3], x[6]); ce_desc(x[9], x[12]); ce_desc(x[11], x[13]);
    ce_desc(x[3], x[5]); ce_desc(x[6], x[8]); ce_desc(x[7], x[9]); ce_desc(x[10], x[12]);
    ce_desc(x[3], x[4]); ce_desc(x[5], x[6]); ce_desc(x[7], x[8]); ce_desc(x[9], x[10]); ce_desc(x[11], x[12]);
    ce_desc(x[6], x[7]); ce_desc(x[8], x[9]);
}
__device__ __forceinline__ void merge16_desc(unsigned (&x)[16]) {
#pragma unroll
    for (int j = 8; j > 0; j >>= 1)
#pragma unroll
        for (int i = 0; i < 16; ++i) { const int l = i ^ j; if (l > i) ce_desc(x[i], x[l]); }
}
__device__ __forceinline__ void top16_merge(unsigned (&L)[16], const unsigned (&Tt)[16]) {
#pragma unroll
    for (int i = 0; i < 16; ++i) L[i] = L[i] > Tt[15 - i] ? L[i] : Tt[15 - i];
    merge16_desc(L);
}
struct QRaw { bf16x8 a[8], b[8]; };
__device__ __forceinline__ void route_load(Frame& F, int tg, int h, QRaw& q) {
    const int lane = F.lane, tok = tg * 32 + (lane & 31), hh = lane >> 5;
    const bf16* qrow = F.QB + (size_t)tok * NQ + h * 256 + 8 * hh;
#pragma unroll
    for (int ks = 0; ks < 8; ++ks) q.a[ks] = *(const GAS bf16x8*)(qrow + ks * 16);
#pragma unroll
    for (int ks = 0; ks < 8; ++ks) q.b[ks] = *(const GAS bf16x8*)(qrow + 128 + ks * 16);
}
__device__ __forceinline__ void route_job(Frame& F, int tg, int h, const QRaw& q) {
    const int lane = F.lane, tok = tg * 32 + (lane & 31), hh = lane >> 5;
    unsigned L1[16], L2[16];
#pragma unroll
    for (int i = 0; i < 16; ++i) { L1[i] = 0u; L2[i] = 0u; }
    bf16x8 bq[8], bqn[8];
#pragma unroll
    for (int ks = 0; ks < 8; ++ks) { bq[ks] = q.a[ks]; bqn[ks] = q.b[ks]; }
#pragma unroll 1
    for (int p = 0; p < 2; ++p) {
        const LAS unsigned short* krow = (const LAS unsigned short*)F.lds + (size_t)(p * 128 + (lane & 31)) * 136 + 8 * hh;
        unsigned L[16];
#pragma unroll
        for (int i = 0; i < 16; ++i) L[i] = 0u;
#pragma unroll 1
        for (int mt = 0; mt < 4; ++mt) { f32x16 acc;
#pragma unroll
            for (int r = 0; r < 16; ++r) acc[r] = 0.f;
#pragma unroll
            for (int ks = 0; ks < 8; ++ks) { const bf16x8 ak = *(const LAS bf16x8*)(krow + mt * 32 * 136 + ks * 16); acc = MFMA32(ak, bq[ks], acc); }
            unsigned Tt[16];
#pragma unroll
            for (int r = 0; r < 16; ++r) { const int n = 32 * mt + (r & 3) + 8 * (r >> 2) + 4 * hh; Tt[r] = (f2sort(acc[r]) & ~0x7Fu) | (unsigned)(127 - n); }
            sort16_desc(Tt); top16_merge(L, Tt); }
        unsigned Pp[16];
#pragma unroll
        for (int i = 0; i < 16; ++i) Pp[i] = (unsigned)__shfl_xor((int)L[i], 32);
        top16_merge(L, Pp);
#pragma unroll
        for (int i = 0; i < 16; ++i) { L1[i] = (p == 0) ? L[i] : L1[i]; L2[i] = (p == 0) ? L2[i] : L[i]; }
#pragma unroll
        for (int ks = 0; ks < 8; ++ks) bq[ks] = bqn[ks];
    }
    float v1[16], v2[16];
#pragma unroll
    for (int i = 0; i < 16; ++i) { v1[i] = sort2f(L1[i] & ~0x7Fu); v2[i] = sort2f(L2[i] & ~0x7Fu); }
    LAS unsigned char* tbl = (LAS unsigned char*)(F.lds + 69632 + F.wave * 2048) + lane;
#pragma unroll
    for (int i = 0; i < 16; ++i) { tbl[i * 64] = (unsigned char)(127u - (L1[i] & 0x7Fu)); tbl[(16 + i) * 64] = (unsigned char)(127u - (L2[i] & 0x7Fu)); }
#define CKEY(i, j) ((f2sort(v1[i] + v2[j]) & ~0xFFu) | (unsigned)(255 - ((i) * 16 + (j))))
    unsigned C[16], G[16];
#pragma unroll
    for (int j = 0; j < 16; ++j) C[j] = CKEY(0, j);
#pragma unroll
    for (int j = 0; j < 8; ++j) G[j] = CKEY(1, j);
#pragma unroll
    for (int j = 0; j < 5; ++j) G[8 + j] = CKEY(2, j);
#pragma unroll
    for (int j = 0; j < 3; ++j) G[13 + j] = CKEY(4, j);
    sort16_desc(G); top16_merge(C, G);
#pragma unroll
    for (int j = 0; j < 4; ++j) G[j] = CKEY(3, j);
    G[4] = CKEY(5, 0); G[5] = CKEY(5, 1); G[6] = CKEY(6, 0); G[7] = CKEY(6, 1); G[8] = CKEY(7, 0); G[9] = CKEY(7, 1);
#pragma unroll
    for (int i = 0; i < 6; ++i) G[10 + i] = CKEY(8 + i, 0);
    sort16_desc(G); top16_merge(C, G);
    insert16(C, CKEY(14, 0)); insert16(C, CKEY(15, 0));
#undef CKEY
    const float m = sort2f(C[0] & ~0xFFu); float e[16]; int id[16]; float sum = 0.f;
#pragma unroll
    for (int r = 0; r < 16; ++r) { e[r] = __expf(sort2f(C[r] & ~0xFFu) - m); sum += e[r]; const int code = 255 - (int)(C[r] & 0xFFu); id[r] = (int)tbl[(code >> 4) * 64] * 128 + (int)tbl[(16 + (code & 15)) * 64]; }
    const float inv = rcp_f(sum);
    if (hh == 0) { int* ip = F.IDX + (size_t)tok * 128 + h * 16;
#pragma unroll
        for (int k = 0; k < 4; ++k) { i32x4 w4;
#pragma unroll
            for (int j = 0; j < 4; ++j) w4[j] = (int)((pk2(0.f, e[4 * k + j] * inv) & 0xffff0000u) | (unsigned)id[4 * k + j]);
            *(GAS i32x4*)(ip + 4 * k) = w4; } }
}

__device__ __forceinline__ float ub0(unsigned w) { return (float)(w & 0xffu); }
__device__ __forceinline__ float ub1(unsigned w) { return (float)((w >> 8) & 0xffu); }
__device__ __forceinline__ float ub2(unsigned w) { return (float)((w >> 16) & 0xffu); }
__device__ __forceinline__ float ub3(unsigned w) { return (float)(w >> 24); }
constexpr int NSMAX = 132;
constexpr unsigned P10_DUMMY = 0xffffffffu;
#ifndef P10_FAKE_W
#define P10_FAKE_W 16384
#endif
__device__ __forceinline__ int pk_i8(float a, float b, float c, float d, float inv) {
    return (int)(((unsigned)(int)rintf(a * inv) & 0xffu) | (((unsigned)(int)rintf(b * inv) & 0xffu) << 8) | (((unsigned)(int)rintf(c * inv) & 0xffu) << 16) | (((unsigned)(int)rintf(d * inv) & 0xffu) << 24)); }
template <bool FAKE> __device__ __forceinline__ void peer_round(Frame& F, int quad) {
    constexpr bool U4 = P10_U4 != 0, V4 = P10_V4 != 0;
    const int lane = F.lane, grp = lane >> 4, i = lane & 15;
    const int tb = quad * 4;
    LAS v2u* lst = (LAS v2u*)(F.lds + F.wave * 4352);
#pragma unroll
    for (int tk = 0; tk < 4; ++tk) { const int t = tb + tk;
        const unsigned wa = (unsigned)F.IDX[(size_t)t * 128 + lane], wb = (unsigned)F.IDX[(size_t)t * 128 + 64 + lane];
        lst[tk * NSMAX + lane] = (v2u){wa & 0xffffu, wa & 0xffff0000u};
        lst[tk * NSMAX + 64 + lane] = (v2u){wb & 0xffffu, wb & 0xffff0000u};
        if (lane < NSMAX - 128) lst[tk * NSMAX + 128 + lane] = (v2u){(unsigned)F.IDX[(size_t)t * 128 + 127] & 0xffffu, 0u}; }
    const int NS = 129;
    const int t = tb + grp; int hq[16]; float sh;
#if G3_I8
    {
      static_assert(P10_U4 != 0, "the int8-activation path below is written for the 4-bit expert records");
      const unsigned char* hp = (const unsigned char*)F.XN + (size_t)t * DM + i * 32; sh = F.SA[t];
      const v4u h0 = *(const GAS v4u*)hp, h1 = *(const GAS v4u*)(hp + 16), h2 = *(const GAS v4u*)(hp + 512), h3 = *(const GAS v4u*)(hp + 528);
      const unsigned hw[16] = {h0.x, h0.y, h0.z, h0.w, h1.x, h1.y, h1.z, h1.w, h2.x, h2.y, h2.z, h2.w, h3.x, h3.y, h3.z, h3.w};
#pragma unroll
      for (int k = 0; k < 8; ++k) { unsigned hi_ = 0u, lo_ = 0u;
#pragma unroll
          for (int e = 0; e < 8; ++e) { const int qv = (int)(signed char)(hw[2 * k + (e >> 2)] >> (8 * (e & 3))); const int lo = ((qv + 8) & 15) - 8, hi = (qv - lo) >> 4; lo_ |= ((unsigned)lo & 15u) << (4 * e); hi_ |= ((unsigned)hi & 15u) << (4 * e); }
          hq[2 * k] = (int)hi_; hq[2 * k + 1] = (int)lo_; } }
#else
    { float hv[64]; float mx = 0.f;
      const int bq = t >> 13; const float* gmv = F.GM + (size_t)bq * 1024; const float* shv = F.MOD + (size_t)bq * 6144 + 3072;
      float ssv = F.SSQ[(size_t)t * 16 + i]; ssv += __shfl_xor(ssv, 1); ssv += __shfl_xor(ssv, 2); ssv += __shfl_xor(ssv, 4); ssv += __shfl_xor(ssv, 8);
      const float rstd = rsq_f(ssv * (1.f / DM) + EPS);
#pragma unroll
      for (int c8 = 0; c8 < 8; ++c8) { const int col = U4 ? ((c8 >> 2) * 512 + i * 32 + (c8 & 3) * 8) : ((c8 >> 1) * 256 + i * 16 + (c8 & 1) * 8); const bf16* hp = F.X1 + (size_t)t * DM + col;
          const v4u w = *(const GAS v4u*)hp; const unsigned ww[4] = {w.x, w.y, w.z, w.w};
          const f32x4 g0 = *(const GAS f32x4*)(gmv + col), g1 = *(const GAS f32x4*)(gmv + col + 4), s0 = *(const GAS f32x4*)(shv + col), s1 = *(const GAS f32x4*)(shv + col + 4);
          const float gg[8] = {g0.x, g0.y, g0.z, g0.w, g1.x, g1.y, g1.z, g1.w}, sv[8] = {s0.x, s0.y, s0.z, s0.w, s1.x, s1.y, s1.z, s1.w};
#pragma unroll
          for (int j = 0; j < 4; ++j) { const float lo = bflo(ww[j]) * rstd * gg[2 * j] + sv[2 * j], hi = bfhi(ww[j]) * rstd * gg[2 * j + 1] + sv[2 * j + 1]; hv[c8 * 8 + 2 * j] = lo; hv[c8 * 8 + 2 * j + 1] = hi; mx = fmaxf(mx, fmaxf(fabsf(lo), fabsf(hi))); } }
      mx = fmaxf(mx, __shfl_xor(mx, 1)); mx = fmaxf(mx, __shfl_xor(mx, 2)); mx = fmaxf(mx, __shfl_xor(mx, 4)); mx = fmaxf(mx, __shfl_xor(mx, 8));
      const float qmax = U4 ? 119.f : 127.f; const float inv = mx > 0.f ? qmax / mx : 0.f; sh = mx / qmax;
#pragma unroll
      for (int k = 0; k < 8; ++k) {
          if (U4) { unsigned hi_ = 0u, lo_ = 0u;
#pragma unroll
              for (int e = 0; e < 8; ++e) { const int qv = (int)rintf(hv[8 * k + e] * inv); const int lo = ((qv + 8) & 15) - 8, hi = (qv - lo) >> 4; lo_ |= ((unsigned)lo & 15u) << (4 * e); hi_ |= ((unsigned)hi & 15u) << (4 * e); }
              hq[2 * k] = (int)hi_; hq[2 * k + 1] = (int)lo_; }
          else { hq[2 * k] = pk_i8(hv[8 * k], hv[8 * k + 1], hv[8 * k + 2], hv[8 * k + 3], inv); hq[2 * k + 1] = pk_i8(hv[8 * k + 4], hv[8 * k + 5], hv[8 * k + 6], hv[8 * k + 7], inv); } } }
#endif
    float y[64]; float asum = 0.f, asum1 = 0.f;
#pragma unroll
    for (int k = 0; k < 64; ++k) y[k] = 0.f;
    LDS_WAIT();
    const LAS v2u* mylst = lst + grp * NSMAX;
#define P10_LOAD(r_, U, V, SU, SV, GT) do { const v2u kg_ = mylst[(r_)]; const int id0_ = (int)kg_.x; const int id_ = FAKE ? (int)((((unsigned)id0_ * 2654435761u) >> 7) & (P10_FAKE_W - 1)) : id0_; GT = __uint_as_float(kg_.y); \
        const unsigned char* ur_ = F.UT + (size_t)id_ * P10_REC; const unsigned char* vr_ = ur_ + P10_UB; \
        if (U4) { U[0] = *(const GAS v4u*)(ur_ + i * 16); U[1] = *(const GAS v4u*)(ur_ + 256 + i * 16); V[0] = *(const GAS v4u*)(vr_ + i * 16); V[1] = *(const GAS v4u*)(vr_ + 256 + i * 16); \
            const v2u sc_ = *(const GAS v2u*)(ur_ + 1024 + i * 8); SU = __uint_as_float(sc_.x); SV = __uint_as_float(sc_.y); }     \
        else { _Pragma("unroll") for (int sg = 0; sg < 4; ++sg) U[sg] = *(const GAS v4u*)(ur_ + sg * 256 + i * 16); SU = F.USC[id_]; \
            _Pragma("unroll") for (int sg = 0; sg < 4; ++sg) V[sg] = *(const GAS v4u*)(vr_ + sg * 256 + i * 16); SV = F.VSC[id_]; } } while (0)
#define P10_COMP(U, V, SU, SV, GT) do { float dact_; \
        if (U4) { const unsigned uw_[8] = {U[0].x, U[0].y, U[0].z, U[0].w, U[1].x, U[1].y, U[1].z, U[1].w}; int d0_ = 0, d1_ = 0; \
            int e0_ = 0, e1_ = 0; \
            _Pragma("unroll") for (int k = 0; k < 4; ++k) { d0_ = __builtin_amdgcn_sdot8((int)uw_[k], hq[2 * k], d0_, false); e0_ = __builtin_amdgcn_sdot8((int)uw_[k], hq[2 * k + 1], e0_, false); } \
            _Pragma("unroll") for (int k = 4; k < 8; ++k) { d1_ = __builtin_amdgcn_sdot8((int)uw_[k], hq[2 * k], d1_, false); e1_ = __builtin_amdgcn_sdot8((int)uw_[k], hq[2 * k + 1], e1_, false); } \
            const unsigned sb_ = __float_as_uint(SU); float df_ = bflo(sb_) * (float)(16 * d0_ + e0_) + bfhi(sb_) * (float)(16 * d1_ + e1_); \
            df_ += __shfl_xor(df_, 1); df_ += __shfl_xor(df_, 2); df_ += __shfl_xor(df_, 4); df_ += __shfl_xor(df_, 8); dact_ = df_ * sh; } \
        else { int d_ = 0; \
            _Pragma("unroll") for (int sg = 0; sg < 4; ++sg) { d_ = __builtin_amdgcn_sdot4((int)U[sg].x, hq[sg * 4], d_, false); d_ = __builtin_amdgcn_sdot4((int)U[sg].y, hq[sg * 4 + 1], d_, false); d_ = __builtin_amdgcn_sdot4((int)U[sg].z, hq[sg * 4 + 2], d_, false); d_ = __builtin_amdgcn_sdot4((int)U[sg].w, hq[sg * 4 + 3], d_, false); } \
            d_ += __shfl_xor(d_, 1); d_ += __shfl_xor(d_, 2); d_ += __shfl_xor(d_, 4); d_ += __shfl_xor(d_, 8); dact_ = (float)d_ * (SU * sh); } \
        const float ag_ = gelu_fast(dact_) * GT; \
        if (V4) { const unsigned vb_ = __float_as_uint(SV); const float a0_ = ag_ * bflo(vb_), a1_ = ag_ * bfhi(vb_); asum += a0_; asum1 += a1_; \
            const unsigned vw_[8] = {V[0].x, V[0].y, V[0].z, V[0].w, V[1].x, V[1].y, V[1].z, V[1].w}; \
            _Pragma("unroll") for (int k = 0; k < 8; ++k) { const unsigned lo_ = vw_[k]; unsigned hi_ = vw_[k] & 0xf0f0f0f0u; asm volatile("" : "+v"(hi_));        \
                const float a_ = k < 4 ? a0_ : a1_;   \
                y[8 * k] += a_ * ub0(lo_); y[8 * k + 1] += a_ * ub1(lo_); y[8 * k + 2] += a_ * ub2(lo_); y[8 * k + 3] += a_ * ub3(lo_); y[8 * k + 4] += a_ * ub0(hi_); y[8 * k + 5] += a_ * ub1(hi_); y[8 * k + 6] += a_ * ub2(hi_); y[8 * k + 7] += a_ * ub3(hi_); } } \
        else { const float a_ = ag_ * SV; asum += a_; \
            _Pragma("unroll") for (int sg = 0; sg < 4; ++sg) { const unsigned xw_[4] = {V[sg].x, V[sg].y, V[sg].z, V[sg].w}; \
                _Pragma("unroll") for (int j = 0; j < 4; ++j) { y[sg * 16 + 4 * j] += a_ * ub0(xw_[j]); y[sg * 16 + 4 * j + 1] += a_ * ub1(xw_[j]); y[sg * 16 + 4 * j + 2] += a_ * ub2(xw_[j]); y[sg * 16 + 4 * j + 3] += a_ * ub3(xw_[j]); } } } } while (0)
#ifndef P10_DEPTH
#define P10_DEPTH 2
#endif
#ifndef P10_LOOP_SHIFT
#define P10_LOOP_SHIFT 1
#endif
#define P10_STR2(x) #x
#define P10_STR(x) P10_STR2(x)
#ifndef P10_FENCED
#define P10_FENCED 0
#endif
#define P10_FENCE do { if (P10_FENCED) __builtin_amdgcn_sched_barrier(0); } while (0)
    if (P10_DEPTH == 3) {
        v4u uA[4], vA[4], uB[4], vB[4], uC[4], vC[4]; float suA, svA, suB, svB, suC, svC, gtA, gtB, gtC;
        const int last = NS - 1;
        P10_LOAD(0, uA, vA, suA, svA, gtA); P10_LOAD(1, uB, vB, suB, svB, gtB);
#pragma unroll 1
        for (int r = 0; r < NS; r += 3) {
            { const int rn = r + 2; P10_LOAD(rn, uC, vC, suC, svC, gtC); } P10_FENCE;
            P10_COMP(uA, vA, suA, svA, gtA); P10_FENCE;
            { const int rn = r + 3 < NS ? r + 3 : last; P10_LOAD(rn, uA, vA, suA, svA, gtA); } P10_FENCE;
            P10_COMP(uB, vB, suB, svB, gtB); P10_FENCE;
            { const int rn = r + 4 < NS ? r + 4 : last; P10_LOAD(rn, uB, vB, suB, svB, gtB); } P10_FENCE;
            P10_COMP(uC, vC, suC, svC, gtC); P10_FENCE;
        }
    } else if (P10_DEPTH == 4) {
        v4u uA[4], vA[4], uB[4], vB[4], uC[4], vC[4], uD[4], vD[4]; float suA, svA, suB, svB, suC, svC, suD, svD, gtA, gtB, gtC, gtD;
        P10_LOAD(0, uA, vA, suA, svA, gtA); P10_LOAD(1, uB, vB, suB, svB, gtB); P10_LOAD(2, uC, vC, suC, svC, gtC);
#pragma unroll 1
        for (int r = 0; r < 128; r += 4) {
            { const int rn = r + 3; P10_LOAD(rn, uD, vD, suD, svD, gtD); } P10_FENCE;
            P10_COMP(uA, vA, suA, svA, gtA); P10_FENCE;
            { const int rn = r + 4 < 128 ? r + 4 : 127; P10_LOAD(rn, uA, vA, suA, svA, gtA); } P10_FENCE;
            P10_COMP(uB, vB, suB, svB, gtB); P10_FENCE;
            { const int rn = r + 5 < 128 ? r + 5 : 127; P10_LOAD(rn, uB, vB, suB, svB, gtB); } P10_FENCE;
            P10_COMP(uC, vC, suC, svC, gtC); P10_FENCE;
            { const int rn = r + 6 < 128 ? r + 6 : 127; P10_LOAD(rn, uC, vC, suC, svC, gtC); } P10_FENCE;
            P10_COMP(uD, vD, suD, svD, gtD); P10_FENCE;
        }
    } else {
        v4u uA[4], vA[4], uB[4], vB[4]; float suA, svA, suB, svB, gtA, gtB;
        P10_LOAD(0, uA, vA, suA, svA, gtA);
        asm volatile(".p2align 8\n\t.rept " P10_STR(P10_LOOP_SHIFT) "\n\ts_nop 0\n\t.endr" ::);
#pragma unroll 1
        for (int r = 0; r < 128; r += 2) {
            { const int rn = r + 1; P10_LOAD(rn, uB, vB, suB, svB, gtB); } P10_FENCE;
            P10_COMP(uA, vA, suA, svA, gtA); P10_FENCE;
            { const int rn = r + 2 < 128 ? r + 2 : 127; P10_LOAD(rn, uA, vA, suA, svA, gtA); } P10_FENCE;
            P10_COMP(uB, vB, suB, svB, gtB); P10_FENCE;
        }
    }
#define P10_YI(m, j) (V4 ? (8 * ((m) >> 1) + 2 * ((m) & 1) + ((j) >> 1) + 4 * ((j) & 1)) : (4 * (m) + (j)))
    { const int b = t >> 13; const float* g2 = F.MOD + (size_t)b * 6144 + 5120; const bf16* xr2 = F.X1 + (size_t)t * DM; float ss = 0.f;
#pragma unroll
      for (int m = 0; m < 16; ++m) { const int col = V4 ? ((m >> 3) * 512 + i * 32 + 4 * (m & 7)) : ((m >> 2) * 256 + i * 16 + 4 * (m & 3)); const float yoff = V4 ? 8.f * (m < 8 ? asum : asum1) : 128.f * asum;
          const v2u xw = *(const GAS v2u*)(xr2 + col); const f32x4 ga = *(const GAS f32x4*)(g2 + col); const float xs[4] = {bflo(xw.x), bfhi(xw.x), bflo(xw.y), bfhi(xw.y)}, gs[4] = {ga.x, ga.y, ga.z, ga.w};
          float yv[4];
#pragma unroll
          for (int j = 0; j < 4; ++j) yv[j] = !V4 ? y[P10_YI(m, j)] : ((j & 1) ? y[P10_YI(m, j)] * 0.0625f : y[P10_YI(m, j)] - y[P10_YI(m, j + 1)]);
#pragma unroll
          for (int j = 0; j < 4; ++j) { const float zz = xs[j] + gs[j] * (yv[j] - yoff); y[P10_YI(m, j)] = zz; ss += zz * zz; } }
      ss += __shfl_xor(ss, 1); ss += __shfl_xor(ss, 2); ss += __shfl_xor(ss, 4); ss += __shfl_xor(ss, 8);
      const float rs = rsq_f(ss * (1.f / DM) + EPS); const float* fg = F.final_g; float* orow = F.out + (size_t)t * DM;
      if (FAKE) { if (i == 0) F.DEC[t] = rs + y[3]; }
      else {
#pragma unroll
      for (int m = 0; m < 16; ++m) { const int col = V4 ? ((m >> 3) * 512 + i * 32 + 4 * (m & 7)) : ((m >> 2) * 256 + i * 16 + 4 * (m & 3)); const f32x4 fa = *(const GAS f32x4*)(fg + col);
          *(GAS f32x4*)(orow + col) = (f32x4){y[P10_YI(m, 0)] * rs * fa.x, y[P10_YI(m, 1)] * rs * fa.y, y[P10_YI(m, 2)] * rs * fa.z, y[P10_YI(m, 3)] * rs * fa.w}; } } }
    LDS_WAIT();
}

struct Args { const float* in[20]; float* out; unsigned char* ws; int ph_lo, ph_hi, li, pad; };
__global__ void __launch_bounds__(NWAVES * 64, 2) hymba_fwd(Args args) {
    extern __shared__ __attribute__((aligned(16))) unsigned char lds[];
    Frame F;
    F.lds = (LAS unsigned char*)lds;
    F.MISC = (volatile LAS unsigned*)(F.lds + MISC_OFF);
    F.tid = threadIdx.x; F.lane = F.tid & 63; F.wave = __builtin_amdgcn_readfirstlane(F.tid >> 6);
    F.G = gridDim.x; { const int bx = blockIdx.x; F.vcu = (F.G % 8 == 0) ? (bx % 8) * (F.G / 8) + bx / 8 : bx; }
    unsigned char* ws = args.ws;
    F.ctl = (gu32*)(ws + WS_CTL);
    F.x = args.in[0]; F.c = args.in[1]; F.ada_w = args.in[2]; F.ada_b = args.in[3]; F.norm1_g = args.in[4]; F.w_in = args.in[5]; F.lb_gamma = args.in[6]; F.hgrn_g = args.in[7];
    F.ln_g = args.in[8]; F.ln_b = args.in[9]; F.sp_w = args.in[10]; F.sp_b = args.in[11]; F.gm_g = args.in[12]; F.w_out = args.in[13]; F.norm2_g = args.in[14]; F.wq = args.in[15];
    F.keys = args.in[16]; F.pu = args.in[17]; F.pv = args.in[18]; F.final_g = args.in[19]; F.out = args.out;
    F.MODP = (float*)(ws + WS_MODP); F.MOD = (float*)(ws + WS_MOD); F.LB = (float*)(ws + WS_LB); F.SW = (float*)(ws + WS_SW); F.SA = (float*)(ws + WS_SA); F.DEC = (float*)(ws + WS_DEC); F.X1 = (bf16*)(ws + WS_X1); F.GATE = (float*)(ws + WS_GATE); F.IDX = (int*)(ws + WS_IDX);
    F.WIN = (bf16*)(ws + WS_WIN); F.WOUT = (bf16*)(ws + WS_WOUT); F.WQ = (bf16*)(ws + WS_WQ); F.KEYS = (bf16*)(ws + WS_KEYS); F.SPW = (bf16*)(ws + WS_SPW);
    F.UT = ws + WS_UT; F.VT = ws + WS_VT; F.USC = (float*)(ws + WS_USC); F.VSC = (float*)(ws + WS_VSC); F.XN = (bf16*)(ws + WS_XN); F.PROJ = (bf16*)(ws + WS_PROJ); F.QB = (bf16*)(ws + WS_PROJ);
    F.STATE = (bf16*)(ws + WS_STATE); F.CAT = (bf16*)(ws + WS_CAT);
    F.QBIAS = (float*)(ws + WS_QBIAS); F.GM = (float*)(ws + WS_GM); F.SSQ = (float*)(ws + WS_SSQ); F.WQF = (bf16*)(ws + WS_WQF);
    for (int u = F.tid; u < (LDS_BYTES - LDSCTL_OFF) / 4; u += NWAVES * 64) ((LAS unsigned*)(F.lds + LDSCTL_OFF))[u] = 0u;
    __syncthreads();
    XcdBarrier bar; bar.bar = (unsigned*)(F.ctl + CW_BAR); bar.x = 0; bar.st = nullptr;
    if (!MK_PER_PHASE) bar = xcd_barrier_post((unsigned*)(F.ctl + CW_BAR), F.MISC + 8);
    const int lo = args.ph_lo, hi = args.ph_hi;
#ifndef PHMASK
#define PHMASK 0x7ff
#endif
#define IN(k) (((PHMASK >> (k)) & 1) && lo <= (k) && (k) < hi)
#define SEAM(k) do { if (IN(k) && IN((k) + 1)) xcd_barrier(bar); } while (0)

#ifndef PHREP
#define PHREP 0
#endif
#ifndef P10_HALF
#define P10_HALF 0
#endif
#define REP2(k) ((PHREP >> (k)) & 1)
#define PH0 do { p0_prologue(F); __syncthreads(); } while (0)
#define PH1 do { p1_norm1(F); __syncthreads(); } while (0)
#if G1_I8
#define PH2 do { pg8::Gemm g{F.XN, F.WIN, T, NPROJ, DM / 2};     \
        pg8::StaticOrder S; S.init(T, NPROJ, F.G, (int)blockIdx.x); pg8::EpiBf16S E{F.PROJ, NPROJ, F.SA, F.SW}; \
        pg8::gemm_phase<pg8::EpiBf16S, pg8::StaticOrder, true, true, true>(F.lds, g, S, E); } while (0)
#else
#define PH2 do { pg8::Gemm g{F.XN, F.WIN, T, NPROJ, DM}; pg8::StaticOrder S; S.init(T, NPROJ, F.G, (int)blockIdx.x); pg8::EpiBf16 E{F.PROJ, NPROJ}; \
        pg8::gemm_phase<pg8::EpiBf16, pg8::StaticOrder, true, true>(F.lds, g, S, E); } while (0)
#endif
#define PH3A do { HRawA ra_, rb_; hgrnA_load(F, F.vcu, ra_);        \
        for (int u = F.vcu; u < 2048; u += 2 * F.G) { hgrnA_load(F, u + F.G, rb_); hgrnA_unit(F, u, ra_); hgrnA_load(F, u + 2 * F.G < 2048 ? u + 2 * F.G : u, ra_); hgrnA_unit(F, u + F.G, rb_); } } while (0)
#define PH3 do { PH3A; for (int u = F.vcu; u < 256; u += F.G) gmlp_unit(F, u); } while (0)
#define PH5 do { HRawC ra_, rb_; hgrnC_load(F, F.vcu, ra_);        \
        for (int u = F.vcu; u < 2048; u += 2 * F.G) { hgrnC_load(F, u + F.G, rb_); hgrnC_unit(F, u, ra_); hgrnC_load(F, u + 2 * F.G < 2048 ? u + 2 * F.G : u, ra_); hgrnC_unit(F, u + F.G, rb_); } } while (0)
#define PH6 do { pg8::Gemm g{F.CAT, F.WOUT, T, DM, DM}; pg8::StaticOrder S; S.init(T, DM, F.G, (int)blockIdx.x); pg8::EpiResid E{F.x, F.X1, F.MOD + 2048, 6144, SEQ, DM, F.SSQ}; \
        pg8::gemm_phase<pg8::EpiResid, pg8::StaticOrder, true, true>(F.lds, g, S, E); } while (0)
#define PH7 do { } while (0)
#if G3_I8
#define PH8 do { pg8::Gemm g{F.XN, F.WQ, T, NQ, DM / 2}; pg8::StaticOrder S; S.init(T, NQ, F.G, (int)blockIdx.x); pg8::EpiBf16S E{F.QB, NQ, F.SA, F.SW + NPROJ}; \
        pg8::gemm_phase<pg8::EpiBf16S, pg8::StaticOrder, true, true, true>(F.lds, g, S, E); } while (0)
#else
#define PH8 do { pg8::Gemm g{F.X1, F.WQF, T, NQ, DM, 5};        \
        pg8::StaticOrder S; S.init(T, NQ, F.G, (int)blockIdx.x); pg8::EpiQ E{F.QB, NQ, F.SSQ, F.QBIAS, 5}; \
        pg8::gemm_phase<pg8::EpiQ, pg8::StaticOrder, true, true>(F.lds, g, S, E); } while (0)
#endif
#define PH9 do {   \
        pg8::StaticOrder S9_; S9_.init(T, NQ, F.G, (int)blockIdx.x); pg8::Unit u9_; \
        for (int i9_ = 0; S9_.next(i9_, u9_); ++i9_) { const int h_ = u9_.pn; QRaw q9_; route_load(F, u9_.pm * 8 + F.wave, h_, q9_);        \
            { v4u kv_[8]; \
              _Pragma("unroll") for (int j_ = 0; j_ < 8; ++j_) { const int c_ = F.tid + 512 * j_; kv_[j_] = *(const GAS v4u*)(F.KEYS + (size_t)(h_ * 256 + (c_ >> 4)) * 128 + (c_ & 15) * 8); } \
              _Pragma("unroll") for (int j_ = 0; j_ < 8; ++j_) { const int c_ = F.tid + 512 * j_; *(LAS v4u*)((LAS unsigned short*)F.lds + (c_ >> 4) * 136 + (c_ & 15) * 8) = kv_[j_]; } } \
            __syncthreads(); \
            route_job(F, u9_.pm * 8 + F.wave, h_, q9_); __syncthreads(); } } while (0)
    if (IN(0)) { PH0; if (REP2(0)) PH0; } SEAM(0);
    if (IN(1)) { PH1; if (REP2(1)) PH1; } SEAM(1);
    if (IN(2)) { PH2; if (REP2(2)) PH2; } SEAM(2);
    if (IN(3)) { PH3; if (REP2(3)) { PH3A; } if (REP2(11)) { for (int u = F.vcu; u < 256; u += F.G) gmlp_unit(F, u); } } SEAM(3);
#ifndef XBARS
#define XBARS 0
#endif
    if (IN(4)) { p4_qbias(F); p4_scan(F); if (REP2(4)) p4_scan(F); for (int xb = 0; xb < XBARS; ++xb) xcd_barrier(bar); } SEAM(4);
    if (IN(5)) { PH5; if (REP2(5)) PH5; } SEAM(5);
    if (IN(6)) { PH6; if (REP2(6)) PH6; } SEAM(6);
    if (IN(8)) { PH8; if (REP2(8)) PH8; VM_WAIT(); __syncthreads(); }
    if (IN(9)) { PH9; if (REP2(9)) PH9; } SEAM(9);
    if (IN(10)) {
        const int gw = F.vcu * NWAVES + F.wave;
        if (REP2(10)) { for (int rd = 0; rd < 4; ++rd) peer_round<false>(F, rd * 2048 + gw); }
#if P10_HALF
        if (F.vcu & 1) return;
        peer_round<false>(F, gw + NWAVES);
#endif
        int q = gw;
        while (q < T / 4) { peer_round<false>(F, q);
            int nq = 0; if (F.lane == 0) nq = (int)__hip_atomic_fetch_add(F.ctl + 16, 1u, __ATOMIC_RELAXED, __HIP_MEMORY_SCOPE_AGENT);
            q = F.G * NWAVES + __builtin_amdgcn_readfirstlane(nq); }
    }
#undef IN
#undef SEAM
}

extern "C" void kernel_launch(void* const* d_in, const int* in_sizes, int n_in, void* d_out, int out_size, void* d_ws, size_t ws_size, hipStream_t stream) {
    static int grid = 0;
    if (grid == 0) {
        if (n_in != 20 || in_sizes[0] != T * DM || out_size != T * DM || ws_size < WS_END) { fprintf(stderr, "kernel_launch: unexpected shapes (n_in %d, in0 %d, out %d, ws %zu); nothing launched\n", n_in, n_in > 0 ? in_sizes[0] : -1, out_size, ws_size); grid = -1; return; }
        if (hipFuncSetAttribute((const void*)hymba_fwd, hipFuncAttributeMaxDynamicSharedMemorySize, LDS_BYTES) != hipSuccess) { fprintf(stderr, "kernel_launch: hipFuncSetAttribute failed\n"); grid = -1; return; }
        int per_cu = 0;
        if (hipOccupancyMaxActiveBlocksPerMultiprocessor(&per_cu, (const void*)hymba_fwd, NWAVES * 64, LDS_BYTES) != hipSuccess || per_cu < 1)
            fprintf(stderr, "kernel_launch: note: occupancy query reports %d workgroups per CU\n", per_cu);
        (void)hipGetLastError();
        grid = 256;
    }
    if (grid < 0) return;
    if (hipMemsetAsync((char*)d_ws + WS_CTL, 0, CTL_ZERO_BYTES, stream) != hipSuccess) { fprintf(stderr, "kernel_launch: hipMemsetAsync failed\n"); return; }
    Args a{};
    for (int i = 0; i < 20; ++i) a.in[i] = (const float*)d_in[i];
    a.out = (float*)d_out; a.ws = (unsigned char*)d_ws;
#if MK_PER_PHASE
    for (int li = 0; li < NPHASE; ++li) { a.ph_lo = li; a.ph_hi = li + 1; a.li = li; hipLaunchKernelGGL(hymba_fwd, dim3(grid), dim3(NWAVES * 64), LDS_BYTES, stream, a); }
#else
    a.ph_lo = 0; a.ph_hi = NPHASE; a.li = 0; hipLaunchKernelGGL(hymba_fwd, dim3(grid), dim3(NWAVES * 64), LDS_BYTES, stream, a);
#endif
    const hipError_t le = hipPeekAtLastError();
    if (le != hipSuccess) fprintf(stderr, "kernel_launch: launch failed: %s\n", hipGetErrorName(le));
}
```

```cpp
#include <hip/hip_runtime.h>
#include <cstdio>
#include <cstdint>
namespace pg8 {
#define PG8_LAS __attribute__((address_space(3)))
typedef unsigned short bf16_t;
typedef short bf16x8 __attribute__((ext_vector_type(8)));
typedef float f32x4 __attribute__((ext_vector_type(4)));
typedef unsigned u32x4 __attribute__((ext_vector_type(4)));
constexpr int BM = 256, BK = 64, HALF = 128, HTB = HALF * BK * 2  , STAGE_BYTES = 8 * HTB, NXCD = 8, WGM = 8;

__host__ __device__ __forceinline__ int lds_byte(int r, int c) { const int st = (r >> 4) * 2 + (c >> 5), rr = r & 15, cc = c & 31, ob = rr * 64 + cc * 2; return st * 1024 + (ob ^ (((ob >> 9) & 1) << 5)); }
__host__ __device__ __forceinline__ void stage_rc(int b, int& R, int& C) { const int st = b / 1024, sb = b % 1024, swz = sb ^ (((sb >> 9) & 1) << 5); R = (st >> 1) * 16 + swz / 64; C = (st & 1) * 32 + (swz % 64) / 2; }
__host__ __device__ __forceinline__ int perm32(int rho) { const int n = rho >> 4, i = rho & 15; return 8 * (i >> 2) + 4 * n + (i & 3); }

struct Unit { int pm, pn; };
struct Gemm { const bf16_t* A; const bf16_t* Bt; int M, N, K; int bsh = -1; };

struct StaticOrder {
    int nM, nN, nwg, G, c;
    __host__ __device__ void init(int M, int N, int G_, int c_) { nM = M / BM; nN = N / BM; nwg = nM * nN; G = G_; c = c_; }
    __host__ __device__ bool next(int i, Unit& u) const {
        const long L = (long)i * G + c; if (L >= nwg) return false;
        int wgid = (int)L; { const int q = nwg / NXCD, r = nwg % NXCD, xcd = wgid % NXCD, off = wgid / NXCD; wgid = (xcd < r ? xcd * (q + 1) : r * (q + 1) + (xcd - r) * q) + off; }
        const int nig = WGM * nN, gid = wgid / nig, fm = gid * WGM, gsz = (nM - fm) < WGM ? (nM - fm) : WGM;
        u.pm = fm + ((wgid % nig) % gsz); u.pn = (wgid % nig) / gsz; return true;
    }
    __device__ __forceinline__ void a_ready(const Unit&) const {}
    __device__ __forceinline__ void done(const Unit&) const {}
};

__device__ __forceinline__ unsigned cvt_pk_bf16(float lo, float hi) { unsigned r; asm volatile("v_cvt_pk_bf16_f32 %0, %1, %2" : "=v"(r) : "v"(lo), "v"(hi)); return r; }
typedef float f32x2 __attribute__((ext_vector_type(2)));

struct EpiBf16 {
    static constexpr bool PERM = true, AFTER_DRAIN = false;
    bf16_t* O; int ldc;
    __device__ __forceinline__ void operator()(const f32x4 (&acc)[2][2][4][2], const Unit& u, int wr, int wc, int fr, int fq) const {
        const int row0 = u.pm * BM + wr * 64 + fr; const int col0 = u.pn * BM + wc * 32 + 8 * fq;
#pragma unroll
        for (int ai = 0; ai < 2; ++ai)
#pragma unroll
            for (int m = 0; m < 4; ++m) { bf16_t* rowp = O + (size_t)(row0 + ai * HALF + m * 16) * ldc + col0;
#pragma unroll
                for (int bj = 0; bj < 2; ++bj) { const f32x4 v0 = acc[ai][bj][m][0], v1 = acc[ai][bj][m][1];
                    u32x4 w; w.x = cvt_pk_bf16(v0[0], v0[1]); w.y = cvt_pk_bf16(v0[2], v0[3]); w.z = cvt_pk_bf16(v1[0], v1[1]); w.w = cvt_pk_bf16(v1[2], v1[3]);
                    *(u32x4*)(rowp + bj * HALF) = w; } }
    }
};
struct EpiBf16S {
    static constexpr bool PERM = true, AFTER_DRAIN = false;
    bf16_t* O; int ldc; const float* sa; const float* sw;
    __device__ __forceinline__ void operator()(const f32x4 (&acc)[2][2][4][2], const Unit& u, int wr, int wc, int fr, int fq) const {
        const int row0 = u.pm * BM + wr * 64 + fr; const int col0 = u.pn * BM + wc * 32 + 8 * fq;
        f32x4 cs[2][2];
#pragma unroll
        for (int bj = 0; bj < 2; ++bj)
#pragma unroll
            for (int n = 0; n < 2; ++n) cs[bj][n] = *(const f32x4*)(sw + col0 + bj * HALF + 4 * n);
#pragma unroll
        for (int ai = 0; ai < 2; ++ai)
#pragma unroll
            for (int m = 0; m < 4; ++m) { const int row = row0 + ai * HALF + m * 16; const float rs = sa[row]; bf16_t* rowp = O + (size_t)row * ldc + col0;
#pragma unroll
                for (int bj = 0; bj < 2; ++bj) { const f32x4 v0 = acc[ai][bj][m][0] * cs[bj][0] * rs, v1 = acc[ai][bj][m][1] * cs[bj][1] * rs;
                    u32x4 w; w.x = cvt_pk_bf16(v0[0], v0[1]); w.y = cvt_pk_bf16(v0[2], v0[3]); w.z = cvt_pk_bf16(v1[0], v1[1]); w.w = cvt_pk_bf16(v1[2], v1[3]);
                    *(u32x4*)(rowp + bj * HALF) = w; } }
    }
};
struct EpiResid {
    static constexpr bool PERM = true, AFTER_DRAIN = false;
    const float* xin; bf16_t* out; const float* gate; int gate_stride; int rows_per_batch; int ldc; float* ssq;
    __device__ __forceinline__ void operator()(const f32x4 (&acc)[2][2][4][2], const Unit& u, int wr, int wc, int fr, int fq) const {
        const int row0 = u.pm * BM + wr * 64 + fr; const int col0 = u.pn * BM + wc * 32 + 8 * fq;
        const float* gp = gate + (size_t)((u.pm * BM) / rows_per_batch) * gate_stride + col0;
        f32x4 gv[2][2];
#pragma unroll
        for (int bj = 0; bj < 2; ++bj)
#pragma unroll
            for (int n = 0; n < 2; ++n) gv[bj][n] = *(const f32x4*)(gp + bj * HALF + 4 * n);
#pragma unroll
        for (int ai = 0; ai < 2; ++ai)
#pragma unroll
            for (int m = 0; m < 4; ++m) { const int row = row0 + ai * HALF + m * 16; const size_t off = (size_t)row * ldc + col0; float s2 = 0.f;
#pragma unroll
                for (int bj = 0; bj < 2; ++bj) { const f32x4 x0 = *(const f32x4*)(xin + off + bj * HALF), x1 = *(const f32x4*)(xin + off + bj * HALF + 4);
                    const f32x4 v0 = x0 + gv[bj][0] * acc[ai][bj][m][0], v1 = x1 + gv[bj][1] * acc[ai][bj][m][1];
                    s2 += (v0[0] * v0[0] + v0[1] * v0[1]) + (v0[2] * v0[2] + v0[3] * v0[3]) + (v1[0] * v1[0] + v1[1] * v1[1]) + (v1[2] * v1[2] + v1[3] * v1[3]);
                    u32x4 w; w.x = cvt_pk_bf16(v0[0], v0[1]); w.y = cvt_pk_bf16(v0[2], v0[3]); w.z = cvt_pk_bf16(v1[0], v1[1]); w.w = cvt_pk_bf16(v1[2], v1[3]);
                    *(u32x4*)(out + off + bj * HALF) = w; }
                s2 += __shfl_xor(s2, 16); s2 += __shfl_xor(s2, 32);
                if (fq == 0) ssq[(size_t)row * 16 + u.pn * 4 + wc] = s2; }
    }
};
struct EpiQ {
    static constexpr bool PERM = true, AFTER_DRAIN = false;
    bf16_t* O; int ldc; const float* ssq; const float* bias; int bsh;
    __device__ __forceinline__ void operator()(const f32x4 (&acc)[2][2][4][2], const Unit& u, int wr, int wc, int fr, int fq) const {
        const int row0 = u.pm * BM + wr * 64 + fr; const int col0 = u.pn * BM + wc * 32 + 8 * fq;
        const float* bp = bias + (size_t)(u.pm >> bsh) * ldc + col0;
        f32x4 bv[2][2];
#pragma unroll
        for (int bj = 0; bj < 2; ++bj)
#pragma unroll
            for (int n = 0; n < 2; ++n) bv[bj][n] = *(const f32x4*)(bp + bj * HALF + 4 * n);
#pragma unroll
        for (int ai = 0; ai < 2; ++ai)
#pragma unroll
            for (int m = 0; m < 4; ++m) { const int row = row0 + ai * HALF + m * 16; const f32x4* sp = (const f32x4*)(ssq + (size_t)row * 16);
                const f32x4 sa = (sp[0] + sp[1]) + (sp[2] + sp[3]); const float rs = __builtin_amdgcn_rsqf(((sa[0] + sa[1]) + (sa[2] + sa[3])) * (1.f / 1024.f) + 1e-6f);
                bf16_t* rowp = O + (size_t)row * ldc + col0;
#pragma unroll
                for (int bj = 0; bj < 2; ++bj) { const f32x4 v0 = acc[ai][bj][m][0] * rs + bv[bj][0], v1 = acc[ai][bj][m][1] * rs + bv[bj][1];
                    u32x4 w; w.x = cvt_pk_bf16(v0[0], v0[1]); w.y = cvt_pk_bf16(v0[2], v0[3]); w.z = cvt_pk_bf16(v1[0], v1[1]); w.w = cvt_pk_bf16(v1[2], v1[3]);
                    *(u32x4*)(rowp + bj * HALF) = w; } }
    }
};

typedef int i32x4 __attribute__((ext_vector_type(4)));
template <bool I8> __device__ __forceinline__ f32x4 mma16(const bf16x8 b, const bf16x8 a, const f32x4 c) {
    if constexpr (I8) return __builtin_bit_cast(f32x4, __builtin_amdgcn_mfma_i32_16x16x64_i8(__builtin_bit_cast(i32x4, b), __builtin_bit_cast(i32x4, a), __builtin_bit_cast(i32x4, c), 0, 0, 0));
    else return __builtin_amdgcn_mfma_f32_16x16x32_bf16(b, a, c, 0, 0, 0);
}
template <class Epi, class Sched, bool ALIGN_EPI = false, bool SP2 = false, bool I8 = false>
__device__ __forceinline__ void gemm_phase(PG8_LAS unsigned char* lds, const Gemm g, const Sched& S, const Epi& E) {
    const int tid = threadIdx.x, wid = __builtin_amdgcn_readfirstlane(tid >> 6), lane = tid & 63, wr = wid >> 2, wc = wid & 3, fr = lane & 15, fq = lane >> 4;
    const int K = g.K, nt = K / BK;
    unsigned voffA[2], voffB[2];
#pragma unroll
    for (int i = 0; i < 2; ++i) { int R, C; stage_rc(tid * 16 + i * 8192, R, C); const int Rb = Epi::PERM ? ((R & ~31) + perm32(R & 31)) : R;
        voffA[i] = (unsigned)(R * K + C) * 2u; voffB[i] = (unsigned)(Rb * K + C) * 2u; }
    const size_t kstep = (size_t)(BK * 2);
    const size_t hstep = (size_t)HALF * K * 2;
    const size_t tstep = 2 * hstep;
    const unsigned ldsw = (unsigned)wid * 1024u;
    const int aoff = lds_byte(wr * 64 + fr, fq * 8), boff = lds_byte(wc * 32 + fr, fq * 8);
#define PG8_SA(b, h) (((b) * 2 + (h)) * HTB)
#define PG8_SB(b, h) ((4 + (b) * 2 + (h)) * HTB)
#define PG8_STAGE(bufoff, gbase, voff) do { _Pragma("unroll") for (int _i = 0; _i < 2; ++_i) \
        __builtin_amdgcn_global_load_lds((const unsigned*)((const char*)(gbase) + (voff)[_i]), (PG8_LAS unsigned*)(lds + (bufoff) + ldsw + _i * 8192), 16, 0, 0); } while (0)
#define PG8_LDA(dst, b, h) do { _Pragma("unroll") for (int m = 0; m < 4; ++m) _Pragma("unroll") for (int k = 0; k < 2; ++k) dst[m][k] = *(const PG8_LAS bf16x8*)(lds + PG8_SA(b, h) + aoff + m * 2048 + k * 1024); } while (0)
#define PG8_LDB(dst, b, h) do { _Pragma("unroll") for (int n = 0; n < 2; ++n) _Pragma("unroll") for (int k = 0; k < 2; ++k) dst[n][k] = *(const PG8_LAS bf16x8*)(lds + PG8_SB(b, h) + boff + n * 2048 + k * 1024); } while (0)
#define PG8_MMA(ai, bj, At, Bt) do { __builtin_amdgcn_s_setprio(1); _Pragma("unroll") for (int m = 0; m < 4; ++m) _Pragma("unroll") for (int n = 0; n < 2; ++n) _Pragma("unroll") for (int k = 0; k < 2; ++k) \
        acc[ai][bj][m][n] = mma16<I8>(Bt[n][k], At[m][k], acc[ai][bj][m][n]); __builtin_amdgcn_s_setprio(0); } while (0)
#define PG8_WAIT_V(n) asm volatile("s_waitcnt vmcnt(" #n ")" ::: "memory")
#define PG8_WAIT_L(n) asm volatile("s_waitcnt lgkmcnt(" #n ")" ::: "memory")
#define PG8_BAR __builtin_amdgcn_s_barrier()
#define PG8_SCHED __builtin_amdgcn_sched_barrier(0)
    Unit cur, nxt; int ui = 0;
    if (!S.next(0, cur)) return;
    f32x4 acc[2][2][4][2];
#pragma unroll
    for (int a = 0; a < 2; ++a)
#pragma unroll
        for (int b = 0; b < 2; ++b)
#pragma unroll
            for (int m = 0; m < 4; ++m)
#pragma unroll
                for (int n = 0; n < 2; ++n) acc[a][b][m][n] = (f32x4){0.f, 0.f, 0.f, 0.f};
    bf16x8 At[4][2], B0[2][2], B1[2][2];
    const char* cA = (const char*)g.A + (size_t)cur.pm * tstep; const char* cB = (const char*)g.Bt + (size_t)(cur.pn + (g.bsh >= 0 ? (cur.pm >> g.bsh) * (g.N / BM) : 0)) * tstep;
    S.a_ready(cur);
    if constexpr (SP2) {
        PG8_STAGE(PG8_SB(0, 0), cB, voffB); PG8_STAGE(PG8_SB(0, 1), cB + hstep, voffB); PG8_STAGE(PG8_SA(0, 0), cA, voffA); PG8_STAGE(PG8_SA(0, 1), cA + hstep, voffA);
        if (wr == 1) PG8_BAR;
        PG8_WAIT_V(2); PG8_BAR;
        PG8_STAGE(PG8_SB(1, 0), cB + kstep, voffB); PG8_STAGE(PG8_SA(1, 0), cA + kstep, voffA); PG8_STAGE(PG8_SB(1, 1), cB + hstep + kstep, voffB);
        PG8_WAIT_V(6); PG8_BAR;
    } else {
        PG8_STAGE(PG8_SB(0, 0), cB, voffB); PG8_STAGE(PG8_SA(0, 0), cA, voffA); PG8_STAGE(PG8_SB(0, 1), cB + hstep, voffB); PG8_STAGE(PG8_SA(0, 1), cA + hstep, voffA);
        if (wr == 1) PG8_BAR;
        PG8_WAIT_V(4); PG8_BAR;
        PG8_STAGE(PG8_SB(1, 0), cB + kstep, voffB); PG8_STAGE(PG8_SA(1, 0), cA + kstep, voffA); PG8_STAGE(PG8_SB(1, 1), cB + hstep + kstep, voffB);
        PG8_WAIT_V(6); PG8_BAR;
    }
    for (;;) {
        const bool has_next = S.next(ui + 1, nxt);
        const char* nA = has_next ? (const char*)g.A + (size_t)nxt.pm * tstep : cA; const char* nB = has_next ? (const char*)g.Bt + (size_t)(nxt.pn + (g.bsh >= 0 ? (nxt.pm >> g.bsh) * (g.N / BM) : 0)) * tstep : cB;
        for (int t = 0; t < nt; t += 2) {
            const bool last = (t == nt - 2);
            const char* a1 = cA + (size_t)(t + 1) * kstep;
            const char* a2 = last ? nA : cA + (size_t)(t + 2) * kstep; const char* b2 = last ? nB : cB + (size_t)(t + 2) * kstep;
            const char* a3 = a2 + kstep; const char* b3 = b2 + kstep;
            if (last && has_next) S.a_ready(nxt);
            if constexpr (SP2) {
            PG8_LDB(B0, 0, 0); PG8_LDB(B1, 0, 1); PG8_SCHED; PG8_LDA(At, 0, 0); PG8_STAGE(PG8_SA(1, 1), a1 + hstep, voffA);
            PG8_WAIT_V(8); PG8_WAIT_L(0); PG8_BAR; PG8_MMA(0, 0, At, B0); PG8_MMA(0, 1, At, B1); PG8_BAR; PG8_SCHED;
            PG8_LDA(At, 0, 1); PG8_STAGE(PG8_SB(0, 0), b2, voffB); PG8_STAGE(PG8_SB(0, 1), b2 + hstep, voffB); PG8_STAGE(PG8_SA(0, 0), a2, voffA);
            PG8_WAIT_V(8); PG8_WAIT_L(0); PG8_BAR; PG8_MMA(1, 0, At, B0); PG8_MMA(1, 1, At, B1); PG8_BAR; PG8_SCHED;
            PG8_LDB(B0, 1, 0); PG8_LDB(B1, 1, 1); PG8_SCHED; PG8_LDA(At, 1, 0); PG8_STAGE(PG8_SA(0, 1), a2 + hstep, voffA);
            PG8_WAIT_V(8); PG8_WAIT_L(0); PG8_BAR; PG8_MMA(0, 0, At, B0); PG8_MMA(0, 1, At, B1); PG8_BAR; PG8_SCHED;
            PG8_LDA(At, 1, 1); PG8_STAGE(PG8_SB(1, 0), b3, voffB); PG8_STAGE(PG8_SB(1, 1), b3 + hstep, voffB); PG8_STAGE(PG8_SA(1, 0), a3, voffA);
            PG8_WAIT_V(8); PG8_WAIT_L(0); PG8_BAR; PG8_MMA(1, 0, At, B0); PG8_MMA(1, 1, At, B1); PG8_BAR; PG8_SCHED;
            } else {
            PG8_LDB(B0, 0, 0); PG8_SCHED; PG8_LDA(At, 0, 0); PG8_STAGE(PG8_SA(1, 1), a1 + hstep, voffA);
            PG8_WAIT_L(8); PG8_BAR; PG8_WAIT_L(0); PG8_MMA(0, 0, At, B0); PG8_BAR; PG8_SCHED;
            PG8_LDB(B1, 0, 1); PG8_STAGE(PG8_SB(0, 0), b2, voffB);
            PG8_BAR; PG8_WAIT_L(0); PG8_MMA(0, 1, At, B1); PG8_BAR;
            PG8_LDA(At, 0, 1); PG8_STAGE(PG8_SA(0, 0), a2, voffA);
            PG8_BAR; PG8_WAIT_L(0); PG8_MMA(1, 0, At, B0); PG8_BAR; PG8_SCHED;
            PG8_STAGE(PG8_SB(0, 1), b2 + hstep, voffB);
            PG8_WAIT_V(6); PG8_BAR; PG8_MMA(1, 1, At, B1); PG8_BAR;
            PG8_LDB(B0, 1, 0); PG8_SCHED; PG8_LDA(At, 1, 0); PG8_STAGE(PG8_SA(0, 1), a2 + hstep, voffA);
            PG8_WAIT_L(8); PG8_BAR; PG8_WAIT_L(0); PG8_MMA(0, 0, At, B0); PG8_BAR; PG8_SCHED;
            PG8_LDB(B1, 1, 1); PG8_STAGE(PG8_SB(1, 0), b3, voffB);
            PG8_BAR; PG8_WAIT_L(0); PG8_MMA(0, 1, At, B1); PG8_BAR;
            PG8_LDA(At, 1, 1); PG8_STAGE(PG8_SA(1, 0), a3, voffA);
            PG8_BAR; PG8_WAIT_L(0); PG8_MMA(1, 0, At, B0); PG8_BAR; PG8_SCHED;
            PG8_STAGE(PG8_SB(1, 1), b3 + hstep, voffB);
            PG8_WAIT_V(6); PG8_BAR; PG8_MMA(1, 1, At, B1); PG8_BAR;
            }
        }
        if constexpr (ALIGN_EPI) { if (wr == 0) PG8_BAR; }
        if constexpr (I8) {
#pragma unroll
            for (int a = 0; a < 2; ++a)
#pragma unroll
                for (int b = 0; b < 2; ++b)
#pragma unroll
                    for (int m = 0; m < 4; ++m)
#pragma unroll
                        for (int n = 0; n < 2; ++n) acc[a][b][m][n] = __builtin_convertvector(__builtin_bit_cast(i32x4, acc[a][b][m][n]), f32x4); }
        if constexpr (!Epi::AFTER_DRAIN) { E(acc, cur, wr, wc, fr, fq); S.done(cur); }
        if (!has_next) break;
#pragma unroll
        for (int a = 0; a < 2; ++a)
#pragma unroll
            for (int b = 0; b < 2; ++b)
#pragma unroll
                for (int m = 0; m < 4; ++m)
#pragma unroll
                    for (int n = 0; n < 2; ++n) acc[a][b][m][n] = (f32x4){0.f, 0.f, 0.f, 0.f};
        cur = nxt; cA = nA; cB = nB; ++ui;
        if constexpr (ALIGN_EPI) { if (wr == 1) PG8_BAR; }
    }
    PG8_WAIT_V(0);
    if constexpr (!ALIGN_EPI) { if (wr == 0) PG8_BAR; }
    PG8_BAR;
    if constexpr (Epi::AFTER_DRAIN) { E.fused(acc, cur, wr, wc, fr, fq, lds, wid, lane); S.done(cur); }
#undef PG8_SA
#undef PG8_SB
#undef PG8_STAGE
#undef PG8_LDA
#undef PG8_LDB
#undef PG8_MMA
#undef PG8_WAIT_V
#undef PG8_WAIT_L
#undef PG8_BAR
#undef PG8_SCHED
}
}


constexpr int NB = 4, SEQ = 8192, DM = 1024, T = NB * SEQ;
constexpr int NPROJ = 3072, HW = 512, HD = 128, HCH = 64;
constexpr int PH = 8, NQ = 2048;
constexpr float EPS = 1e-6f;
constexpr int NWAVES = 8;
#ifndef G1_I8
#define G1_I8 1
#endif
#ifndef G3_I8
#define G3_I8 0
#endif
static_assert(G3_I8 == 0, "the folded second rmsnorm (query GEMM on x1 with per-batch folded weights) is written for the bf16 query GEMM");
#ifndef P10_U4
#define P10_U4 1
#endif
#ifndef P10_V4
#define P10_V4 1
#endif
#ifndef P10_VFP4
#define P10_VFP4 1
#endif
static_assert(P10_U4 == P10_V4, "the record layouts below are all-8-bit or all-4-bit");
constexpr int P10_UB = P10_U4 ? 512 : 1024, P10_REC = P10_U4 ? 1152 : 2048;
#ifndef MK_PER_PHASE
#define MK_PER_PHASE 0
#endif
constexpr int NPHASE = 11;

constexpr size_t MiB = 1u << 20;
constexpr size_t WS_CTL = 0, CTL_ZERO_BYTES = 1 * MiB;
constexpr size_t WS_MODP = 1 * MiB;
constexpr size_t WS_MOD = 1 * MiB + 800 * 1024;
constexpr size_t WS_LB = 1 * MiB + 900 * 1024;
constexpr size_t WS_SW = 1 * MiB + 910 * 1024;
constexpr size_t WS_SA = 498 * MiB;
constexpr int CW_COLMAX = 65536;
constexpr size_t WS_WIN = 2 * MiB, WS_WOUT = 8 * MiB, WS_WQ = 10 * MiB, WS_KEYS = 14 * MiB, WS_SPW = 15 * MiB;
constexpr size_t WS_UT = 16 * MiB, WS_VT = 32 * MiB;
constexpr size_t WS_USC = 48 * MiB, WS_VSC = 48 * MiB + 65536;
constexpr size_t WS_QBIAS = 52 * MiB;
constexpr size_t WS_GM = 52 * MiB + 65536;
constexpr size_t WS_SSQ = 53 * MiB;
constexpr size_t WS_WQF = 56 * MiB;
constexpr size_t WS_XN = 80 * MiB;
constexpr size_t WS_PROJ = 144 * MiB;
constexpr size_t WS_STATE = 336 * MiB;
constexpr size_t WS_X1 = 272 * MiB;
constexpr size_t WS_DEC = 400 * MiB;
constexpr size_t WS_CAT = 402 * MiB;
constexpr size_t WS_IDX = 466 * MiB, WS_GATE = 482 * MiB;
constexpr size_t WS_END = 499 * MiB;
constexpr int CW_BAR = 4096;

constexpr int RING_BYTES = 131072;
constexpr int LDSCTL_OFF = RING_BYTES, MISC_OFF = LDSCTL_OFF + 320;
constexpr int LDS_BYTES = 147456;
constexpr int LDS_SPARE = 135168;

#define GAS __attribute__((address_space(1)))
#define LAS __attribute__((address_space(3)))
typedef unsigned short bf16;
typedef unsigned v4u __attribute__((ext_vector_type(4)));
typedef unsigned v2u __attribute__((ext_vector_type(2)));
typedef float f32x4 __attribute__((ext_vector_type(4)));
typedef float f32x16 __attribute__((ext_vector_type(16)));
typedef float f32x2 __attribute__((ext_vector_type(2)));
typedef int i32x4 __attribute__((ext_vector_type(4)));
typedef short bf16x8 __attribute__((ext_vector_type(8)));
typedef GAS unsigned gu32;
#define LDS_WAIT() asm volatile("s_waitcnt lgkmcnt(0)" ::: "memory")
#define VM_WAIT() asm volatile("s_waitcnt vmcnt(0)" ::: "memory")
__device__ __forceinline__ unsigned pk2(float lo, float hi) { unsigned r; asm("v_cvt_pk_bf16_f32 %0, %1, %2" : "=v"(r) : "v"(lo), "v"(hi)); return r; }
__device__ __forceinline__ unsigned f2bf(float f) { return pk2(f, 0.f) & 0xffffu; }
__device__ __forceinline__ unsigned f2bf_sw(float f) { unsigned u = __builtin_bit_cast(unsigned, f); return (u + 0x7fffu + ((u >> 16) & 1u)) >> 16; }
__device__ __forceinline__ unsigned pk2_sw(float lo, float hi) { return f2bf_sw(lo) | (f2bf_sw(hi) << 16); }
__device__ __forceinline__ float bf2f(unsigned short h) { return __uint_as_float((unsigned)h << 16); }
__device__ __forceinline__ float bflo(unsigned w) { return __uint_as_float(w << 16); }
__device__ __forceinline__ float bfhi(unsigned w) { return __uint_as_float(w & 0xffff0000u); }
__device__ __forceinline__ float rcp_f(float x) { return __builtin_amdgcn_rcpf(x); }
__device__ __forceinline__ float rsq_f(float x) { return __builtin_amdgcn_rsqf(x); }
__device__ __forceinline__ float silu_f(float x) { return x * rcp_f(1.f + __expf(-x)); }
__device__ __forceinline__ float gelu_div(float x) { const float z = 0.7978845608f * (x + 0.044715f * x * x * x); const float e = __expf(2.f * z); return x * (1.f - 1.f / (1.f + e)); }
__device__ __forceinline__ float gelu_fast(float x) { const float e = __builtin_amdgcn_exp2f(2.3022082f * (x + 0.044715f * x * x * x)); return x * (1.f - __builtin_amdgcn_rcpf(1.f + e)); }
__device__ __forceinline__ float gelu_f(float x) { const float z = 0.7978845608f * (x + 0.044715f * x * x * x); const float e = __expf(2.f * z); return x * (1.f - rcp_f(1.f + e)); }

#define XB_TMO      128
#define XB_XCNT(j)  (256  + 64 * (j))
#define XB_XSUB(j)  (1280 + 64 * (j))
#define XB_XGEN(j)  (2304 + 64 * (j))
#define XB_TOP      3328
#define XB_TOPGEN   3392
#define XCD_BAR_WORDS 3456
#define XB_SPIN_CAP (1u << 18)

__device__ __forceinline__ unsigned xb_ld(unsigned* p)              { return __hip_atomic_load(p, __ATOMIC_RELAXED, __HIP_MEMORY_SCOPE_AGENT); }
__device__ __forceinline__ unsigned xb_add(unsigned* p, unsigned v) { return __hip_atomic_fetch_add(p, v, __ATOMIC_RELAXED, __HIP_MEMORY_SCOPE_AGENT); }
__device__ __forceinline__ unsigned xb_xcc_id() { return (unsigned)__builtin_amdgcn_s_getreg((3 << 11) | 20) & 0xFu; }
#define XB_SPIN(cond, bar) do { unsigned _sp = 0; while (cond) { __builtin_amdgcn_s_sleep(1); \
    if ((++_sp & 255u) == 0u) { if (xb_ld(&(bar)[XB_TMO])) break; if (_sp > XB_SPIN_CAP) { atomicAdd(&(bar)[XB_TMO], 1u); break; } } } } while (0)

struct XcdBarrier {
    unsigned* bar; unsigned x;
    volatile LAS unsigned* st;
};

__device__ __forceinline__ XcdBarrier xcd_barrier_post(unsigned* bar, volatile LAS unsigned* st) {
    XcdBarrier b; b.bar = bar; b.x = xb_xcc_id(); b.st = st;
    if (threadIdx.x == 0) (void)xb_add(&bar[XB_XCNT(b.x)], 1u);
    return b;
}
__device__ __forceinline__ void xcd_barrier_complete(unsigned* bar, unsigned x, unsigned& nloc, unsigned& nx) {
    const unsigned G = gridDim.x * gridDim.y * gridDim.z;
    unsigned sum, cnt, mine, sp = 0u;
    for (;;) {
        sum = 0u; cnt = 0u; mine = 0u;
#pragma unroll
        for (unsigned j = 0; j < 16; ++j) { const unsigned c = xb_ld(&bar[XB_XCNT(j)]); sum += c; cnt += (c > 0u) ? 1u : 0u; mine = (j == x) ? c : mine; }
        if (sum == G) break;
        __builtin_amdgcn_s_sleep(1);
        if ((++sp & 255u) == 0u) { if (xb_ld(&bar[XB_TMO])) break; if (sp > XB_SPIN_CAP) { atomicAdd(&bar[XB_TMO], 1u); break; } }
    }
    nloc = mine > 0u ? mine : 1u; nx = cnt > 0u ? cnt : 1u;
}

__device__ __forceinline__ void xcd_barrier(const XcdBarrier& b) {
    asm volatile("s_waitcnt vmcnt(0)" ::: "memory");
    __syncthreads();
    if (threadIdx.x == 0) {
        unsigned* bar = b.bar;
        __builtin_amdgcn_s_waitcnt(0);
        unsigned nloc = b.st[0], nx = b.st[1];
        if (nloc == 0u) { xcd_barrier_complete(bar, b.x, nloc, nx); b.st[0] = nloc; b.st[1] = nx; }
        const unsigned old = xb_add(&bar[XB_XSUB(b.x)], 1u);
        const unsigned gen = old / nloc;
        if (old + 1u == (gen + 1u) * nloc) {
            __builtin_amdgcn_fence(__ATOMIC_RELEASE, "agent");
            asm volatile("s_waitcnt vmcnt(0)" ::: "memory");
            const unsigned og = xb_add(&bar[XB_TOP], 1u);
            const unsigned tg = og / nx;
            if (og + 1u == (tg + 1u) * nx) xb_add(&bar[XB_TOPGEN], 1u);
            else XB_SPIN(xb_ld(&bar[XB_TOPGEN]) == tg, bar);
            __builtin_amdgcn_fence(__ATOMIC_ACQUIRE, "agent");
            xb_add(&bar[XB_XGEN(b.x)], 1u);
            asm volatile("s_waitcnt vmcnt(0)" ::: "memory");
        } else {
            XB_SPIN(xb_ld(&bar[XB_XGEN(b.x)]) == gen, bar);
            __builtin_amdgcn_fence(__ATOMIC_ACQUIRE, "agent");
            asm volatile("s_waitcnt vmcnt(0)" ::: "memory");
        }
    }
    __syncthreads();
}


struct Frame {
    LAS unsigned char* lds;
    volatile LAS unsigned* MISC;
    gu32* ctl;
    int tid, lane, wave, vcu, G;
    const float *x, *c, *ada_w, *ada_b, *norm1_g, *w_in, *lb_gamma, *hgrn_g, *ln_g, *ln_b, *sp_w, *sp_b, *gm_g, *w_out, *norm2_g, *wq, *keys, *pu, *pv, *final_g;
    float* out;
    float *MODP, *MOD, *LB, *DEC, *GATE, *SW, *SA, *QBIAS, *GM, *SSQ; bf16 *X1, *WQF;
    int* IDX;
    bf16 *WIN, *WOUT, *WQ, *KEYS, *SPW, *XN, *PROJ, *QB, *STATE, *CAT;
    unsigned char *UT, *VT; float *USC, *VSC;
};

__device__ __forceinline__ float wave_sum(float v) {
#pragma unroll
    for (int o = 1; o < 64; o <<= 1) v += __shfl_xor(v, o);
    return v;
}
__device__ __forceinline__ void p0_transpose_item(const float* W, int K, int N, bf16* WT, int row_off, LAS float* scr, int item, int lane) {
    const int nblk = N / 32, kb = item / nblk, nb = item % nblk, k0 = 64 * kb, n0 = 32 * nb;
#pragma unroll
    for (int i = 0; i < 32; ++i) { const int kk = 2 * i + (lane >> 5); scr[kk * 33 + (lane & 31)] = W[(size_t)(k0 + kk) * N + n0 + (lane & 31)]; }
    LDS_WAIT(); asm volatile("" ::: "memory");
    const int c = lane & 7;
#pragma unroll
    for (int j = 0; j < 4; ++j) { const int n = (lane >> 3) + 8 * j; const LAS float* s = scr + (8 * c) * 33 + n;
        v4u o; o.x = pk2(s[0 * 33], s[1 * 33]); o.y = pk2(s[2 * 33], s[3 * 33]); o.z = pk2(s[4 * 33], s[5 * 33]); o.w = pk2(s[6 * 33], s[7 * 33]);
        *(GAS v4u*)(WT + (size_t)(row_off + n0 + n) * K + k0 + 8 * c) = o; }
    LDS_WAIT(); asm volatile("" ::: "memory");
}
__device__ __forceinline__ void p1_fold_item(const float* W, int K, int N, bf16* WT, const LAS float* gm, LAS float* scr, int item, int lane) {
    const int nblk = N / 32, kb = item / nblk, nb = item % nblk, k0 = 64 * kb, n0 = 32 * nb;
#pragma unroll
    for (int i = 0; i < 32; ++i) { const int kk = 2 * i + (lane >> 5); scr[kk * 33 + (lane & 31)] = W[(size_t)(k0 + kk) * N + n0 + (lane & 31)] * gm[k0 + kk]; }
    LDS_WAIT(); asm volatile("" ::: "memory");
    const int c = lane & 7;
#pragma unroll
    for (int j = 0; j < 4; ++j) { const int n = (lane >> 3) + 8 * j; const LAS float* s = scr + (8 * c) * 33 + n;
        v4u o; o.x = pk2(s[0 * 33], s[1 * 33]); o.y = pk2(s[2 * 33], s[3 * 33]); o.z = pk2(s[4 * 33], s[5 * 33]); o.w = pk2(s[6 * 33], s[7 * 33]);
        *(GAS v4u*)(WT + (size_t)(n0 + n) * K + k0 + 8 * c) = o; }
    LDS_WAIT(); asm volatile("" ::: "memory");
}
__device__ __forceinline__ void p0_colmax_item(const float* W, int N, unsigned* colmax, int item, int lane) {
    const int nblk = N / 32, kb = item / nblk, nb = item % nblk, k0 = 64 * kb, n0 = 32 * nb; float m = 0.f;
#pragma unroll
    for (int i = 0; i < 32; ++i) { const int kk = 2 * i + (lane >> 5); m = fmaxf(m, fabsf(W[(size_t)(k0 + kk) * N + n0 + (lane & 31)])); }
    m = fmaxf(m, __shfl_xor(m, 32));
    if (lane < 32) atomicMax(colmax + n0 + lane, __float_as_uint(m));
}
__device__ __forceinline__ void p1_qtranspose_item(const float* W, int K, int N, unsigned char* WT, const unsigned* colmax, float* sw, LAS float* scr, int item, int lane) {
    const int nblk = N / 32, kb = item / nblk, nb = item % nblk, k0 = 64 * kb, n0 = 32 * nb;
#pragma unroll
    for (int i = 0; i < 32; ++i) { const int kk = 2 * i + (lane >> 5); scr[kk * 33 + (lane & 31)] = W[(size_t)(k0 + kk) * N + n0 + (lane & 31)]; }
    LDS_WAIT(); asm volatile("" ::: "memory");
    const int c = lane & 7;
#pragma unroll
    for (int j = 0; j < 4; ++j) { const int n = (lane >> 3) + 8 * j; const LAS float* sp = scr + (8 * c) * 33 + n;
        const float mx = __uint_as_float(__hip_atomic_load(colmax + n0 + n, __ATOMIC_RELAXED, __HIP_MEMORY_SCOPE_AGENT)), inv = mx > 0.f ? 127.f / mx : 0.f;
        unsigned lo = 0u, hi = 0u;
#pragma unroll
        for (int e = 0; e < 4; ++e) { lo |= ((unsigned)(int)rintf(sp[e * 33] * inv) & 0xffu) << (8 * e); hi |= ((unsigned)(int)rintf(sp[(4 + e) * 33] * inv) & 0xffu) << (8 * e); }
        *(GAS v2u*)(WT + (size_t)(n0 + n) * K + k0 + 8 * c) = (v2u){lo, hi};
        if (kb == 0 && c == 0) sw[n0 + n] = mx * (1.f / 127.f); }
    LDS_WAIT(); asm volatile("" ::: "memory");
}
__device__ __forceinline__ void cvt8(const float* src, bf16* dst) {
    const f32x4 a = *(const GAS f32x4*)src, b = *(const GAS f32x4*)(src + 4);
    v4u o; o.x = pk2(a.x, a.y); o.y = pk2(a.z, a.w); o.z = pk2(b.x, b.y); o.w = pk2(b.z, b.w);
    *(GAS v4u*)dst = o;
}

__device__ __forceinline__ void p0_prologue(Frame& F) {
    LAS float* cact = (LAS float*)(F.lds);
    LAS float* red = (LAS float*)(F.lds + 16384);
#pragma unroll
    for (int j = 0; j < 8; ++j) { const int i = F.tid + 512 * j; const float v = F.c[i]; cact[i] = v * rcp_f(1.f + __expf(-v)); }
    __syncthreads();
    for (int it = F.vcu; it < 192; it += F.G) {
        const int cg = it % 24, kg = it / 24, k0 = kg * 128 + F.wave * 16, col = cg * 256 + 4 * F.lane;
        f32x4 w[16];
#pragma unroll
        for (int i = 0; i < 16; ++i) w[i] = *(const GAS f32x4*)(F.ada_w + (size_t)(k0 + i) * 6144 + col);
        f32x4 a[4];
#pragma unroll
        for (int b = 0; b < 4; ++b) a[b] = (f32x4){0.f, 0.f, 0.f, 0.f};
#pragma unroll
        for (int i = 0; i < 16; ++i)
#pragma unroll
            for (int b = 0; b < 4; ++b) a[b] += w[i] * cact[b * 1024 + k0 + i];
#pragma unroll
        for (int b = 0; b < 4; ++b) *(LAS f32x4*)(red + (F.wave * 4 + b) * 256 + 4 * F.lane) = a[b];
        __syncthreads();
        for (int o = F.tid; o < 1024; o += 512) { float s = 0.f;
#pragma unroll
            for (int w8 = 0; w8 < 8; ++w8) s += red[w8 * 1024 + o];
            F.MODP[(size_t)(kg * 4 + (o >> 8)) * 6144 + cg * 256 + (o & 255)] = s; }
        __syncthreads();
    }
    {
        LAS float* scr = (LAS float*)(F.lds + F.wave * 16384);
        const int gw = F.vcu * NWAVES + F.wave, NGW = F.G * NWAVES;
        constexpr int I_IN = (DM / 64) * (NPROJ / 32), I_OUT = (DM / 64) * (DM / 32), I_Q = (DM / 64) * (NQ / 32);
        for (int it = gw; it < I_IN + I_OUT + (G3_I8 ? I_Q : 0); it += NGW) {
            int r = it;
            if (r < I_IN) { p0_colmax_item(F.w_in, NPROJ, (unsigned*)(F.ctl + CW_COLMAX), r, F.lane); continue; } r -= I_IN;
            if (r < I_OUT) { p0_transpose_item(F.w_out, DM, DM, F.WOUT, 0, scr, r, F.lane); continue; } r -= I_OUT;
            p0_colmax_item(F.wq, NQ, (unsigned*)(F.ctl + CW_COLMAX) + NPROJ, r, F.lane);
        }
    }
    const int gt = F.vcu * 512 + F.tid, NT = F.G * 512;
    for (int i = gt; i < (PH * 2 * 128 * 128) / 8; i += NT) cvt8(F.keys + (size_t)i * 8, F.KEYS + (size_t)i * 8);
    for (int i = gt; i < (4 * 128 * 128) / 8; i += NT) { const int s0 = (i & 15) * 8, tt = (i >> 4) & 127;
        const f32x4 a = *(const GAS f32x4*)(F.sp_w + (size_t)i * 8), b = *(const GAS f32x4*)(F.sp_w + (size_t)i * 8 + 4);
        float v[8] = {a.x, a.y, a.z, a.w, b.x, b.y, b.z, b.w};
#pragma unroll
        for (int j = 0; j < 8; ++j) v[j] = (s0 + j <= tt) ? v[j] : 0.f;
        v4u o; o.x = pk2(v[0], v[1]); o.y = pk2(v[2], v[3]); o.z = pk2(v[4], v[5]); o.w = pk2(v[6], v[7]);
        *(GAS v4u*)(F.SPW + (size_t)i * 8) = o; }
    for (int i = gt; i < HW; i += NT) { const float g0 = F.lb_gamma[i], g1 = F.lb_gamma[HW + i]; F.LB[i] = 1.f / (1.f + __expf(g1 - g0)); }
    {
        const int gw = F.vcu * NWAVES + F.wave, NGW = F.G * NWAVES;
        for (int r0 = gw; r0 < 2 * 16384; r0 += 2 * NGW) {
            f32x4 vv[2][4];
#pragma unroll
            for (int k = 0; k < 2; ++k) { const int r = r0 + k * NGW; const bool isv = r >= 16384; const int row = isv ? r - 16384 : r;
                const GAS f32x4* src = (const GAS f32x4*)((isv ? F.pv : F.pu) + (size_t)row * DM) + F.lane;
#pragma unroll
                for (int j = 0; j < 4; ++j) vv[k][j] = src[64 * j]; }
#pragma unroll
            for (int k = 0; k < 2; ++k) { const int r = r0 + k * NGW; const bool isv = r >= 16384; const int row = isv ? r - 16384 : r;
            unsigned char* part = F.UT + (size_t)row * P10_REC + (isv ? P10_UB : 0);
            f32x4 v[4];
#pragma unroll
            for (int j = 0; j < 4; ++j) v[j] = vv[k][j];
            if (isv ? (P10_V4 != 0) : (P10_U4 != 0)) {
                const int off = isv ? 8 : 0;
#pragma unroll
                for (int j = 0; j < 4; ++j) {
                    float mp = fmaxf(fmaxf(v[j].x, v[j].y), fmaxf(v[j].z, v[j].w)), mn = fmaxf(fmaxf(-v[j].x, -v[j].y), fmaxf(-v[j].z, -v[j].w));
                    mp = fmaxf(mp, __shfl_xor(mp, 1)); mp = fmaxf(mp, __shfl_xor(mp, 2)); mp = fmaxf(mp, __shfl_xor(mp, 4));
                    mn = fmaxf(mn, __shfl_xor(mn, 1)); mn = fmaxf(mn, __shfl_xor(mn, 2)); mn = fmaxf(mn, __shfl_xor(mn, 4));
                    const float ssgn = mp >= mn ? -mp * 0.125f : mn * 0.125f;
                    const unsigned ab = f2bf(fabsf(ssgn)); const unsigned sb = ab | (ssgn < 0.f ? 0x8000u : 0u); const float sc = __uint_as_float(sb << 16), inv = ab != 0u ? 1.f / sc : 0.f;
                    const float xs[4] = {v[j].x, v[j].y, v[j].z, v[j].w}; unsigned pk = 0u;
                    if (isv && P10_VFP4) {
                        const float mg = fmaxf(mp, mn); const unsigned ab6 = f2bf(mg * (1.f / 6.f)); const float sc6 = __uint_as_float(ab6 << 16), inv6 = ab6 != 0u ? 1.f / sc6 : 0.f;
#pragma unroll
                        for (int e = 0; e < 4; ++e) { const float a = fabsf(xs[e]) * inv6;
                            const unsigned code = (unsigned)(a >= 0.25f) + (unsigned)(a >= 0.75f) + (unsigned)(a >= 1.25f) + (unsigned)(a >= 1.75f) + (unsigned)(a >= 2.5f) + (unsigned)(a >= 3.5f) + (unsigned)(a >= 5.f);
                            pk |= (code | (xs[e] < 0.f ? 8u : 0u)) << (4 * e); }
                        *(GAS unsigned short*)(part + 128 * j + 2 * F.lane) = (unsigned short)pk;
                        if ((F.lane & 7) == 0) { const int g = 8 * j + (F.lane >> 3); *(GAS unsigned short*)(F.UT + (size_t)row * P10_REC + 1024 + 8 * (g & 15) + 4 + 2 * (g >> 4)) = (unsigned short)ab6; }
                        continue; }
#pragma unroll
                    for (int e = 0; e < 4; ++e) { int q = (int)rintf(xs[e] * inv); q = q < -8 ? -8 : (q > 7 ? 7 : q); pk |= ((unsigned)(q + off) & 15u) << (4 * e); }
                    *(GAS unsigned short*)(part + 128 * j + 2 * F.lane) = (unsigned short)pk;
                    if ((F.lane & 7) == 0) { const int g = 8 * j + (F.lane >> 3); *(GAS unsigned short*)(F.UT + (size_t)row * P10_REC + 1024 + 8 * (g & 15) + (isv ? 4 : 0) + 2 * (g >> 4)) = (unsigned short)sb; } }
            } else {
                float mx = 0.f;
#pragma unroll
                for (int j = 0; j < 4; ++j) mx = fmaxf(mx, fmaxf(fmaxf(fabsf(v[j].x), fabsf(v[j].y)), fmaxf(fabsf(v[j].z), fabsf(v[j].w))));
#pragma unroll
                for (int o = 1; o < 64; o <<= 1) mx = fmaxf(mx, __shfl_xor(mx, o));
                const float inv = mx > 0.f ? 127.f / mx : 0.f; const int off = isv ? 128 : 0;
                GAS unsigned* dst = (GAS unsigned*)part + F.lane;
#pragma unroll
                for (int j = 0; j < 4; ++j) { const unsigned b0 = (unsigned)((int)rintf(v[j].x * inv) + off) & 0xffu, b1 = (unsigned)((int)rintf(v[j].y * inv) + off) & 0xffu, b2 = (unsigned)((int)rintf(v[j].z * inv) + off) & 0xffu, b3 = (unsigned)((int)rintf(v[j].w * inv) + off) & 0xffu;
                    dst[64 * j] = b0 | (b1 << 8) | (b2 << 16) | (b3 << 24); }
                if (F.lane == 0) (isv ? F.VSC : F.USC)[row] = mx * (1.f / 127.f); } } }
    }
}

__device__ __forceinline__ void norm_row_to_bf16(const float* xrow, bf16* orow, const f32x4 (&gs)[4], const f32x4 (&sh)[4], int lane) {
    const GAS f32x4* xr = (const GAS f32x4*)xrow + lane;
    f32x4 v[4]; float s2 = 0.f;
#pragma unroll
    for (int j = 0; j < 4; ++j) { v[j] = xr[64 * j]; s2 += (v[j].x * v[j].x + v[j].y * v[j].y) + (v[j].z * v[j].z + v[j].w * v[j].w); }
    const float rstd = rsq_f(wave_sum(s2) * (1.f / DM) + EPS);
    GAS v2u* o8 = (GAS v2u*)orow + lane;
#pragma unroll
    for (int j = 0; j < 4; ++j) { const f32x4 y = v[j] * rstd * gs[j] + sh[j]; v2u o; o.x = pk2(y.x, y.y); o.y = pk2(y.z, y.w); o8[64 * j] = o; }
}

__device__ __forceinline__ void norm_bf16row_to_bf16(const bf16* xrow, bf16* orow, const f32x4 (&gs)[4], const f32x4 (&sh)[4], int lane) {
    const GAS v2u* xr = (const GAS v2u*)xrow + lane;
    f32x4 v[4]; float s2 = 0.f;
#pragma unroll
    for (int j = 0; j < 4; ++j) { const v2u w = xr[64 * j]; v[j] = (f32x4){bflo(w.x), bfhi(w.x), bflo(w.y), bfhi(w.y)}; s2 += (v[j].x * v[j].x + v[j].y * v[j].y) + (v[j].z * v[j].z + v[j].w * v[j].w); }
    const float rstd = rsq_f(wave_sum(s2) * (1.f / DM) + EPS);
    GAS v2u* o8 = (GAS v2u*)orow + lane;
#pragma unroll
    for (int j = 0; j < 4; ++j) { const f32x4 y = v[j] * rstd * gs[j] + sh[j]; v2u o; o.x = pk2(y.x, y.y); o.y = pk2(y.z, y.w); o8[64 * j] = o; }
}

__device__ __forceinline__ void norm_rows4_f32(const float* x0, bf16* o0, const f32x4 (&gs)[4], const f32x4 (&sh)[4], int lane) {
    f32x4 v[4][4];
#pragma unroll
    for (int r = 0; r < 4; ++r)
#pragma unroll
        for (int j = 0; j < 4; ++j) v[r][j] = ((const GAS f32x4*)(x0 + (size_t)r * DM) + lane)[64 * j];
#pragma unroll
    for (int r = 0; r < 4; ++r) { float s2 = 0.f;
#pragma unroll
        for (int j = 0; j < 4; ++j) s2 += (v[r][j].x * v[r][j].x + v[r][j].y * v[r][j].y) + (v[r][j].z * v[r][j].z + v[r][j].w * v[r][j].w);
        const float rstd = rsq_f(wave_sum(s2) * (1.f / DM) + EPS); GAS v2u* o8 = (GAS v2u*)(o0 + (size_t)r * DM) + lane;
#pragma unroll
        for (int j = 0; j < 4; ++j) { const f32x4 y = v[r][j] * rstd * gs[j] + sh[j]; v2u o; o.x = pk2(y.x, y.y); o.y = pk2(y.z, y.w); o8[64 * j] = o; } }
}
__device__ __forceinline__ void norm_rows4_bf16(const bf16* x0, bf16* o0, const f32x4 (&gs)[4], const f32x4 (&sh)[4], int lane) {
    v2u w[4][4];
#pragma unroll
    for (int r = 0; r < 4; ++r)
#pragma unroll
        for (int j = 0; j < 4; ++j) w[r][j] = ((const GAS v2u*)(x0 + (size_t)r * DM) + lane)[64 * j];
#pragma unroll
    for (int r = 0; r < 4; ++r) { f32x4 v[4]; float s2 = 0.f;
#pragma unroll
        for (int j = 0; j < 4; ++j) { v[j] = (f32x4){bflo(w[r][j].x), bfhi(w[r][j].x), bflo(w[r][j].y), bfhi(w[r][j].y)}; s2 += (v[j].x * v[j].x + v[j].y * v[j].y) + (v[j].z * v[j].z + v[j].w * v[j].w); }
        const float rstd = rsq_f(wave_sum(s2) * (1.f / DM) + EPS); GAS v2u* o8 = (GAS v2u*)(o0 + (size_t)r * DM) + lane;
#pragma unroll
        for (int j = 0; j < 4; ++j) { const f32x4 y = v[j] * rstd * gs[j] + sh[j]; v2u o; o.x = pk2(y.x, y.y); o.y = pk2(y.z, y.w); o8[64 * j] = o; } }
}

__device__ __forceinline__ void norm_store_i8(const f32x4 (&v)[4], float rstd, const f32x4 (&gs)[4], const f32x4 (&sh)[4], unsigned char* orow, float* sa, int lane) {
    f32x4 y[4]; float mx = 0.f;
#pragma unroll
    for (int j = 0; j < 4; ++j) { y[j] = v[j] * rstd * gs[j] + sh[j]; mx = fmaxf(mx, fmaxf(fmaxf(fabsf(y[j].x), fabsf(y[j].y)), fmaxf(fabsf(y[j].z), fabsf(y[j].w)))); }
#pragma unroll
    for (int o = 1; o < 64; o <<= 1) mx = fmaxf(mx, __shfl_xor(mx, o));
    const float inv = mx > 0.f ? 119.f / mx : 0.f; GAS unsigned* o4 = (GAS unsigned*)orow + lane;
#pragma unroll
    for (int j = 0; j < 4; ++j) o4[64 * j] = ((unsigned)(int)rintf(y[j].x * inv) & 0xffu) | (((unsigned)(int)rintf(y[j].y * inv) & 0xffu) << 8) | (((unsigned)(int)rintf(y[j].z * inv) & 0xffu) << 16) | (((unsigned)(int)rintf(y[j].w * inv) & 0xffu) << 24);
    if (lane == 0) *sa = mx * (1.f / 119.f);
}
__device__ __forceinline__ void norm_rows4_f32_i8(const float* x0, unsigned char* o0, float* sa0, const f32x4 (&gs)[4], const f32x4 (&sh)[4], int lane) {
    f32x4 v[4][4];
#pragma unroll
    for (int r = 0; r < 4; ++r)
#pragma unroll
        for (int j = 0; j < 4; ++j) v[r][j] = ((const GAS f32x4*)(x0 + (size_t)r * DM) + lane)[64 * j];
#pragma unroll
    for (int r = 0; r < 4; ++r) { float s2 = 0.f;
#pragma unroll
        for (int j = 0; j < 4; ++j) s2 += (v[r][j].x * v[r][j].x + v[r][j].y * v[r][j].y) + (v[r][j].z * v[r][j].z + v[r][j].w * v[r][j].w);
        norm_store_i8(v[r], rsq_f(wave_sum(s2) * (1.f / DM) + EPS), gs, sh, o0 + (size_t)r * DM, sa0 + r, lane); }
}
__device__ __forceinline__ void norm_rows4_bf16_i8(const bf16* x0, unsigned char* o0, float* sa0, const f32x4 (&gs)[4], const f32x4 (&sh)[4], int lane) {
    v2u w[4][4];
#pragma unroll
    for (int r = 0; r < 4; ++r)
#pragma unroll
        for (int j = 0; j < 4; ++j) w[r][j] = ((const GAS v2u*)(x0 + (size_t)r * DM) + lane)[64 * j];
#pragma unroll
    for (int r = 0; r < 4; ++r) { f32x4 v[4]; float s2 = 0.f;
#pragma unroll
        for (int j = 0; j < 4; ++j) { v[j] = (f32x4){bflo(w[r][j].x), bfhi(w[r][j].x), bflo(w[r][j].y), bfhi(w[r][j].y)}; s2 += (v[j].x * v[j].x + v[j].y * v[j].y) + (v[j].z * v[j].z + v[j].w * v[j].w); }
        norm_store_i8(v, rsq_f(wave_sum(s2) * (1.f / DM) + EPS), gs, sh, o0 + (size_t)r * DM, sa0 + r, lane); }
}

__device__ __forceinline__ void p1_norm1(Frame& F) {
    LAS float* modl = (LAS float*)(F.lds);
    const int b = F.vcu >> 6;
    {
        float sv[6];
#pragma unroll
        for (int j = 0; j < 6; ++j) { const int n = ((j >> 1) == 2 ? 4096 : (j >> 1) * 1024) + (j & 1) * 512 + F.tid; float s = F.ada_b[n];
#pragma unroll
            for (int kg = 0; kg < 8; ++kg) s += F.MODP[(size_t)(kg * 4 + b) * 6144 + n];
            sv[j] = s; }
#pragma unroll
        for (int j = 0; j < 6; ++j) { const int n = ((j >> 1) == 2 ? 4096 : (j >> 1) * 1024) + (j & 1) * 512 + F.tid; modl[n] = sv[j]; if ((F.vcu & 63) == 0) F.MOD[(size_t)b * 6144 + n] = sv[j]; }
        if ((F.vcu & 63) == 0) {
#pragma unroll
            for (int j = 0; j < 6; ++j) { const int n = ((j >> 1) == 2 ? 5120 : 2048 + (j >> 1) * 1024) + (j & 1) * 512 + F.tid; float s = F.ada_b[n];
#pragma unroll
                for (int kg = 0; kg < 8; ++kg) s += F.MODP[(size_t)(kg * 4 + b) * 6144 + n];
                F.MOD[(size_t)b * 6144 + n] = s; } }
    }
    __syncthreads();
    LAS float* gml = (LAS float*)(F.lds + LDS_SPARE);
    for (int n = F.tid; n < 1024; n += 512) { const float gv = F.norm2_g[n] * (1.f + modl[4096 + n]); gml[n] = gv; if ((F.vcu & 63) == 0) F.GM[(size_t)b * 1024 + n] = gv; }
    f32x4 gs[4], sh[4];
#pragma unroll
    for (int j = 0; j < 4; ++j) { const int c0 = 256 * j + 4 * F.lane; const f32x4 g = *(const GAS f32x4*)(F.norm1_g + c0);
        const f32x4 sc = *(LAS f32x4*)(modl + 1024 + c0); sh[j] = *(LAS f32x4*)(modl + c0); gs[j] = g * (sc + 1.f); }
    const int r0 = F.vcu * 128 + F.wave * 16;
    for (int i = 0; i < 16; i += 4) { if (G1_I8) norm_rows4_f32_i8(F.x + (size_t)(r0 + i) * DM, (unsigned char*)F.XN + (size_t)(r0 + i) * DM, F.SA + r0 + i, gs, sh, F.lane);
        else norm_rows4_f32(F.x + (size_t)(r0 + i) * DM, F.XN + (size_t)(r0 + i) * DM, gs, sh, F.lane); }
    __syncthreads();
    {
        LAS float* scr = (LAS float*)(F.lds + F.wave * 16384);
        const int gw = F.vcu * NWAVES + F.wave, NGW = F.G * NWAVES;
        constexpr int I_IN = (DM / 64) * (NPROJ / 32), I_Q = (DM / 64) * (NQ / 32);
        for (int it = gw; it < I_IN; it += NGW) { if (G1_I8) p1_qtranspose_item(F.w_in, DM, NPROJ, (unsigned char*)F.WIN, (const unsigned*)(F.ctl + CW_COLMAX), F.SW, scr, it, F.lane); else p0_transpose_item(F.w_in, DM, NPROJ, F.WIN, 0, scr, it, F.lane); }
        for (int it = (F.vcu & 63) * NWAVES + F.wave; it < I_Q; it += 64 * NWAVES) p1_fold_item(F.wq, DM, NQ, F.WQF + (size_t)b * NQ * DM, gml, scr, it, F.lane);
    }
    __syncthreads();
}
__device__ __forceinline__ void p7_norm2(Frame& F) {
    const int b = F.vcu >> 6; const float* mod = F.MOD + (size_t)b * 6144;
    f32x4 gs[4], sh[4];
#pragma unroll
    for (int j = 0; j < 4; ++j) { const int c0 = 256 * j + 4 * F.lane; const f32x4 g = *(const GAS f32x4*)(F.norm2_g + c0);
        const f32x4 sc = *(const GAS f32x4*)(mod + 4096 + c0); sh[j] = *(const GAS f32x4*)(mod + 3072 + c0); gs[j] = g * (sc + 1.f); }
    const int r0 = F.vcu * 128 + F.wave * 16;
    for (int i = 0; i < 16; i += 4) { if (G3_I8) norm_rows4_bf16_i8(F.X1 + (size_t)(r0 + i) * DM, (unsigned char*)F.XN + (size_t)(r0 + i) * DM, F.SA + r0 + i, gs, sh, F.lane);
        else norm_rows4_bf16(F.X1 + (size_t)(r0 + i) * DM, F.XN + (size_t)(r0 + i) * DM, gs, sh, F.lane); }
}

#define MFMA16(a, b, c) __builtin_amdgcn_mfma_f32_16x16x32_bf16((a), (b), (c), 0, 0, 0)
#define MFMA32(a, b, c) __builtin_amdgcn_mfma_f32_32x32x16_bf16((a), (b), (c), 0, 0, 0)

struct HRawA { unsigned short z[16], v[16]; };
__device__ __forceinline__ void hgrnA_load(Frame& F, int u, HRawA& r) {
    const int bh = u >> 7, c = u & 127, b = bh >> 2, h = bh & 3, t0 = b * SEQ + c * HCH;
    const int col = F.tid & 127, rg = F.tid >> 7;
    const bf16* pz = F.PROJ + (size_t)(t0 + rg * 16) * NPROJ + HW + h * HD + col;
    const bf16* pv = pz + HW;
#pragma unroll
    for (int i = 0; i < 16; ++i) { r.z[i] = pz[(size_t)i * NPROJ]; r.v[i] = pv[(size_t)i * NPROJ]; }
}
__device__ __forceinline__ void hgrnA_unit(Frame& F, int u, const HRawA& r) {
    const int bh = u >> 7, c = u & 127, b = bh >> 2, h = bh & 3, t0 = b * SEQ + c * HCH; (void)t0; (void)c; (void)b;
    const int col = F.tid & 127, rg = F.tid >> 7;
    LAS unsigned short* KT = (LAS unsigned short*)(F.lds);
    LAS unsigned short* VT = (LAS unsigned short*)(F.lds + 18432);
    LAS float* TOT = (LAS float*)(F.lds + 36864);
    const float lbv = F.LB[h * HD + col], oml = 1.f - lbv;
    float lg[16], kk[16]; unsigned vv[16]; float run = 0.f;
#pragma unroll
    for (int i = 0; i < 16; ++i) { const float z = bf2f(r.z[i]); const float e = __expf(-z), s = rcp_f(1.f + e);
        run += __logf(lbv + oml * s); lg[i] = run; kk[i] = oml * e * s; vv[i] = r.v[i]; }
    TOT[rg * 128 + col] = run;
    __syncthreads();
    float pre = 0.f, tot = 0.f;
#pragma unroll
    for (int g = 0; g < 4; ++g) { const float tv = TOT[g * 128 + col]; pre += (g < rg) ? tv : 0.f; tot += tv; }
    unsigned kw[8], vw[8];
#pragma unroll
    for (int i = 0; i < 8; ++i) { kw[i] = pk2(kk[2 * i] * __expf(-(pre + lg[2 * i])), kk[2 * i + 1] * __expf(-(pre + lg[2 * i + 1]))); vw[i] = vv[2 * i] | (vv[2 * i + 1] << 16); }
    *(LAS v4u*)(KT + col * 72 + rg * 16) = (v4u){kw[0], kw[1], kw[2], kw[3]}; *(LAS v4u*)(KT + col * 72 + rg * 16 + 8) = (v4u){kw[4], kw[5], kw[6], kw[7]};
    *(LAS v4u*)(VT + col * 72 + rg * 16) = (v4u){vw[0], vw[1], vw[2], vw[3]}; *(LAS v4u*)(VT + col * 72 + rg * 16 + 8) = (v4u){vw[4], vw[5], vw[6], vw[7]};
    if (rg == 0) F.DEC[(size_t)u * 128 + col] = __expf(tot);
    __syncthreads();
    const int fr = F.lane & 15, fq = F.lane >> 4, w = F.wave;
    bf16x8 a[2];
#pragma unroll
    for (int ks = 0; ks < 2; ++ks) a[ks] = *(LAS bf16x8*)(KT + (16 * w + fr) * 72 + ks * 32 + fq * 8);
    bf16* st = F.STATE + (size_t)u * 16384;
#pragma unroll
    for (int n = 0; n < 8; ++n) { f32x4 acc = (f32x4){0.f, 0.f, 0.f, 0.f};
#pragma unroll
        for (int ks = 0; ks < 2; ++ks) { const bf16x8 bb = *(LAS bf16x8*)(VT + (16 * n + fr) * 72 + ks * 32 + fq * 8); acc = MFMA16(a[ks], bb, acc); }
        v2u o; o.x = pk2_sw(acc[0], acc[1]); o.y = pk2_sw(acc[2], acc[3]);
        *(GAS v2u*)(st + (16 * n + fr) * 128 + 16 * w + 4 * fq) = o; }
    __syncthreads();
}

__device__ __forceinline__ void gmlp_unit(Frame& F, int u) {
    const int b = u >> 6, n = u & 63, t0 = b * SEQ + n * 128, t = F.tid >> 2, q = F.tid & 3;
    LAS unsigned short* VnT = (LAS unsigned short*)(F.lds);
    LAS float* Og = (LAS float*)(F.lds + 34816);
    const bf16* prow = F.PROJ + (size_t)(t0 + t) * NPROJ;
    float sum = 0.f, sq = 0.f;
#pragma unroll
    for (int g = 0; g < 4; ++g)
#pragma unroll
        for (int k = 0; k < 4; ++k) { const v4u w = *(const GAS v4u*)(prow + 2560 + g * 128 + (4 * k + q) * 8);
            const unsigned ww[4] = {w.x, w.y, w.z, w.w};
#pragma unroll
            for (int j = 0; j < 4; ++j) { const float lo = gelu_f(bflo(ww[j])), hi = gelu_f(bfhi(ww[j])); sum += lo + hi; sq += lo * lo + hi * hi; } }
    sum += __shfl_xor(sum, 1); sum += __shfl_xor(sum, 2); sq += __shfl_xor(sq, 1); sq += __shfl_xor(sq, 2);
    const float mean = sum * (1.f / 512.f); const float var = fmaxf(sq * (1.f / 512.f) - mean * mean, 0.f);
    const float rstd = rsq_f(var + EPS);
    const int fr = F.lane & 15, fq = F.lane >> 4, w = F.wave;
    for (int g = 0; g < 4; ++g) {
#pragma unroll
        for (int k = 0; k < 4; ++k) { const int lc = (4 * k + q) * 8, ch = g * 128 + lc;
            const v4u wv = *(const GAS v4u*)(prow + 2560 + ch); const unsigned ww[4] = {wv.x, wv.y, wv.z, wv.w};
            const f32x4 lga = *(const GAS f32x4*)(F.ln_g + ch), lgb = *(const GAS f32x4*)(F.ln_g + ch + 4), lba = *(const GAS f32x4*)(F.ln_b + ch), lbb = *(const GAS f32x4*)(F.ln_b + ch + 4);
            const float lgs[8] = {lga.x, lga.y, lga.z, lga.w, lgb.x, lgb.y, lgb.z, lgb.w}, lbs[8] = {lba.x, lba.y, lba.z, lba.w, lbb.x, lbb.y, lbb.z, lbb.w};
#pragma unroll
            for (int j = 0; j < 4; ++j) { const float lo = gelu_f(bflo(ww[j])), hi = gelu_f(bfhi(ww[j]));
                VnT[(lc + 2 * j) * 136 + t] = (unsigned short)f2bf((lo - mean) * rstd * lgs[2 * j] + lbs[2 * j]);
                VnT[(lc + 2 * j + 1) * 136 + t] = (unsigned short)f2bf((hi - mean) * rstd * lgs[2 * j + 1] + lbs[2 * j + 1]); } }
        v4u uw[4];
#pragma unroll
        for (int k = 0; k < 4; ++k) uw[k] = *(const GAS v4u*)(prow + 2048 + g * 128 + (4 * k + q) * 8);
        __syncthreads();
        bf16x8 a[4];
#pragma unroll
        for (int ks = 0; ks < 4; ++ks) a[ks] = *(const GAS bf16x8*)(F.SPW + (size_t)(g * 128 + 16 * w + fr) * 128 + ks * 32 + fq * 8);
        f32x4 sb;
#pragma unroll
        for (int r = 0; r < 4; ++r) sb[r] = F.sp_b[g * 128 + 16 * w + 4 * fq + r];
#pragma unroll
        for (int nn = 0; nn < 8; ++nn) { f32x4 acc = (f32x4){0.f, 0.f, 0.f, 0.f};
#pragma unroll
            for (int ks = 0; ks < 4; ++ks) { const bf16x8 bb = *(LAS bf16x8*)(VnT + (16 * nn + fr) * 136 + ks * 32 + fq * 8); acc = MFMA16(a[ks], bb, acc); }
#pragma unroll
            for (int r = 0; r < 4; ++r) Og[(16 * w + 4 * fq + r) * 132 + 16 * nn + fr] = acc[r] + sb[r]; }
        __syncthreads();
        float gm[32]; float ss = 0.f;
#pragma unroll
        for (int k = 0; k < 4; ++k) { const int lc = (4 * k + q) * 8; const unsigned ww[4] = {uw[k].x, uw[k].y, uw[k].z, uw[k].w};
            const f32x4 ma = *(LAS f32x4*)(Og + t * 132 + lc), mb = *(LAS f32x4*)(Og + t * 132 + lc + 4); const float ms[8] = {ma.x, ma.y, ma.z, ma.w, mb.x, mb.y, mb.z, mb.w};
#pragma unroll
            for (int j = 0; j < 4; ++j) { const float g0 = gelu_f(bflo(ww[j])) * ms[2 * j], g1 = gelu_f(bfhi(ww[j])) * ms[2 * j + 1]; gm[k * 8 + 2 * j] = g0; gm[k * 8 + 2 * j + 1] = g1; ss += g0 * g0 + g1 * g1; } }
        ss += __shfl_xor(ss, 1); ss += __shfl_xor(ss, 2);
        const float rs = rsq_f(ss * (1.f / 128.f) + EPS);
#pragma unroll
        for (int k = 0; k < 4; ++k) { const int lc = (4 * k + q) * 8; v4u o; const f32x4 ga = *(const GAS f32x4*)(F.gm_g + g * 128 + lc), gb = *(const GAS f32x4*)(F.gm_g + g * 128 + lc + 4);
            o.x = pk2(gm[k * 8 + 0] * rs * ga.x, gm[k * 8 + 1] * rs * ga.y); o.y = pk2(gm[k * 8 + 2] * rs * ga.z, gm[k * 8 + 3] * rs * ga.w);
            o.z = pk2(gm[k * 8 + 4] * rs * gb.x, gm[k * 8 + 5] * rs * gb.y); o.w = pk2(gm[k * 8 + 6] * rs * gb.z, gm[k * 8 + 7] * rs * gb.w);
            *(GAS v4u*)(F.CAT + (size_t)(t0 + t) * DM + 512 + g * 128 + lc) = o; }
    }
    __syncthreads();
}

__device__ __forceinline__ void p4_qbias(Frame& F) {
    LAS float* red = (LAS float*)(F.lds + LDS_SPARE);
    const int ks = F.tid >> 3, c = F.tid & 7, n = F.vcu * 8 + c; float a[4] = {0.f, 0.f, 0.f, 0.f};
#pragma unroll
    for (int kk = 0; kk < 16; ++kk) { const int k = ks * 16 + kk; const float w = F.wq[(size_t)k * NQ + n];
#pragma unroll
        for (int b = 0; b < 4; ++b) a[b] += F.MOD[(size_t)b * 6144 + 3072 + k] * w; }
#pragma unroll
    for (int b = 0; b < 4; ++b) red[ks * 32 + b * 8 + c] = a[b];
    __syncthreads();
    if (F.tid < 32) { float s = 0.f;
        for (int j = 0; j < 64; ++j) s += red[j * 32 + F.tid];
        F.QBIAS[(size_t)(F.tid >> 3) * NQ + F.vcu * 8 + (F.tid & 7)] = s; }
}
__device__ __forceinline__ void p4_scan(Frame& F) {
    const int bh = F.vcu >> 4, e = ((F.vcu & 15) * 512 + F.tid) * 2, dk = e & 127;
    const bf16* st = F.STATE + (size_t)bh * 128 * 16384 + e; bf16* so = F.XN + (size_t)bh * 128 * 16384 + e; const float* dc = F.DEC + (size_t)bh * 128 * 128 + dk;
    float s0 = 0.f, s1 = 0.f;
    for (int c0 = 0; c0 < 128; c0 += 32) {
        unsigned l[32]; float d0[32], d1[32];
#pragma unroll
        for (int i = 0; i < 32; ++i) { l[i] = *(const GAS unsigned*)(st + (size_t)(c0 + i) * 16384); const f32x2 dd = *(const GAS f32x2*)(dc + (size_t)(c0 + i) * 128); d0[i] = dd.x; d1[i] = dd.y; }
#pragma unroll
        for (int i = 0; i < 32; ++i) { *(GAS unsigned*)(so + (size_t)(c0 + i) * 16384) = pk2(s0, s1); s0 = d0[i] * (s0 + bflo(l[i])); s1 = d1[i] * (s1 + bfhi(l[i])); }
    }
}

struct HRawC { unsigned z[16], v[16], q[16]; };
__device__ __forceinline__ void hgrnC_load(Frame& F, int u, HRawC& R) {
    const int bh = u >> 7, c = u & 127, b = bh >> 2, h = bh & 3, t0 = b * SEQ + c * HCH, col = F.tid & 127, rg = F.tid >> 7;
    const bf16* pq = F.PROJ + (size_t)(t0 + rg * 16) * NPROJ + h * HD + col;
#pragma unroll
    for (int i = 0; i < 16; ++i) { R.z[i] = pq[(size_t)i * NPROJ + HW]; R.v[i] = pq[(size_t)i * NPROJ + 2 * HW]; R.q[i] = pq[(size_t)i * NPROJ]; }
}
__device__ __forceinline__ void hgrnC_unit(Frame& F, int u, const HRawC& R) {
    const int bh = u >> 7, c = u & 127, b = bh >> 2, h = bh & 3, t0 = b * SEQ + c * HCH;
    const int col = F.tid & 127, rg = F.tid >> 7;
    LAS unsigned short* Qs = (LAS unsigned short*)(F.lds);
    LAS unsigned short* Ks = (LAS unsigned short*)(F.lds + 17408);
    LAS unsigned short* VT = (LAS unsigned short*)(F.lds + 34816);
    LAS unsigned short* Ps = (LAS unsigned short*)(F.lds + 53248);
    LAS float* TOT = (LAS float*)(F.lds + 62464);
    LAS float* Os = (LAS float*)(F.lds + 64512);
    const float lbv = F.LB[h * HD + col], oml = 1.f - lbv;
    float lg[16], kk[16], qq[16]; unsigned vv[16]; float run = 0.f;
#pragma unroll
    for (int i = 0; i < 16; ++i) { const float z = bf2f((unsigned short)R.z[i]); const float e = __expf(-z), s = rcp_f(1.f + e);
        run += __logf(lbv + oml * s); lg[i] = run; kk[i] = oml * e * s; vv[i] = R.v[i]; qq[i] = silu_f(bf2f((unsigned short)R.q[i])); }
    TOT[rg * 128 + col] = run;
    __syncthreads();
    float pre = 0.f;
#pragma unroll
    for (int g = 0; g < 4; ++g) { const float tv = TOT[g * 128 + col]; pre += (g < rg) ? tv : 0.f; }
    unsigned vw[8];
#pragma unroll
    for (int i = 0; i < 16; ++i) { const float bb = pre + lg[i]; Qs[(rg * 16 + i) * 136 + col] = (unsigned short)f2bf(qq[i] * __expf(bb)); Ks[(rg * 16 + i) * 136 + col] = (unsigned short)f2bf(kk[i] * __expf(-bb)); }
#pragma unroll
    for (int i = 0; i < 8; ++i) vw[i] = vv[2 * i] | (vv[2 * i + 1] << 16);
    *(LAS v4u*)(VT + col * 72 + rg * 16) = (v4u){vw[0], vw[1], vw[2], vw[3]}; *(LAS v4u*)(VT + col * 72 + rg * 16 + 8) = (v4u){vw[4], vw[5], vw[6], vw[7]};
    __syncthreads();
    const int fr = F.lane & 15, fq = F.lane >> 4, w = F.wave;
    {
        const int tt = w >> 1;
#pragma unroll
        for (int j = 0; j < 2; ++j) { const int st = (w & 1) * 2 + j; f32x4 acc = (f32x4){0.f, 0.f, 0.f, 0.f};
            if (st <= tt) {
#pragma unroll
                for (int ks = 0; ks < 4; ++ks) { const bf16x8 aa = *(LAS bf16x8*)(Qs + (16 * tt + fr) * 136 + ks * 32 + fq * 8); const bf16x8 bb = *(LAS bf16x8*)(Ks + (16 * st + fr) * 136 + ks * 32 + fq * 8); acc = MFMA16(aa, bb, acc); } }
#pragma unroll
            for (int r = 0; r < 4; ++r) { const int tr = 16 * tt + 4 * fq + r, sc = 16 * st + fr; Ps[tr * 72 + sc] = (unsigned short)f2bf_sw(sc <= tr ? acc[r] : 0.f); } }
    }
    __syncthreads();
    {
        bf16x8 bi[2], bs[4]; const bf16* st = F.XN + (size_t)u * 16384 + (size_t)(16 * w + fr) * 128 + fq * 8;
#pragma unroll
        for (int ks = 0; ks < 2; ++ks) bi[ks] = *(LAS bf16x8*)(VT + (16 * w + fr) * 72 + ks * 32 + fq * 8);
#pragma unroll
        for (int ks = 0; ks < 4; ++ks) bs[ks] = *(const GAS bf16x8*)(st + ks * 32);
#pragma unroll
        for (int tt = 0; tt < 4; ++tt) { f32x4 acc = (f32x4){0.f, 0.f, 0.f, 0.f};
#pragma unroll
            for (int ks = 0; ks < 2; ++ks) { const bf16x8 aa = *(LAS bf16x8*)(Ps + (16 * tt + fr) * 72 + ks * 32 + fq * 8); acc = MFMA16(aa, bi[ks], acc); }
#pragma unroll
            for (int ks = 0; ks < 4; ++ks) { const bf16x8 aa = *(LAS bf16x8*)(Qs + (16 * tt + fr) * 136 + ks * 32 + fq * 8); acc = MFMA16(aa, bs[ks], acc); }
#pragma unroll
            for (int r = 0; r < 4; ++r) Os[(16 * tt + 4 * fq + r) * 132 + 16 * w + fr] = acc[r]; }
    }
    __syncthreads();
    {
        const int row = F.tid >> 3, cs = (F.tid & 7) * 16; float o[16]; float ss = 0.f;
#pragma unroll
        for (int k = 0; k < 4; ++k) { const f32x4 v = *(LAS f32x4*)(Os + row * 132 + cs + 4 * k); o[4 * k] = v.x; o[4 * k + 1] = v.y; o[4 * k + 2] = v.z; o[4 * k + 3] = v.w; ss += (v.x * v.x + v.y * v.y) + (v.z * v.z + v.w * v.w); }
        ss += __shfl_xor(ss, 1); ss += __shfl_xor(ss, 2); ss += __shfl_xor(ss, 4);
        const float rs = rsq_f(ss * (1.f / 128.f) + EPS);
        const bf16* pog = F.PROJ + (size_t)(t0 + row) * NPROJ + 3 * HW + h * HD + cs; const float* gg = F.hgrn_g + h * HD + cs;
        bf16* orow = F.CAT + (size_t)(t0 + row) * DM + h * HD + cs;
#pragma unroll
        for (int k = 0; k < 2; ++k) { const v4u gw = *(const GAS v4u*)(pog + 8 * k); const unsigned ww[4] = {gw.x, gw.y, gw.z, gw.w}; unsigned ow[4];
#pragma unroll
            for (int j = 0; j < 4; ++j) { const int i0 = 8 * k + 2 * j; ow[j] = pk2(o[i0] * rs * gg[i0] * silu_f(bflo(ww[j])), o[i0 + 1] * rs * gg[i0 + 1] * silu_f(bfhi(ww[j]))); }
            *(GAS v4u*)(orow + 8 * k) = (v4u){ow[0], ow[1], ow[2], ow[3]}; }
    }
    __syncthreads();
}

__device__ __forceinline__ unsigned f2sort(float f) { const unsigned u = __float_as_uint(f); return (u & 0x80000000u) ? ~u : (u | 0x80000000u); }
__device__ __forceinline__ float sort2f(unsigned s) { const unsigned u = (s & 0x80000000u) ? (s & 0x7fffffffu) : ~s; return __uint_as_float(u); }
__device__ __forceinline__ void insert16(unsigned (&L)[16], unsigned x) {
#pragma unroll
    for (int i = 0; i < 16; ++i) { const unsigned hi = L[i] > x ? L[i] : x; x = L[i] > x ? x : L[i]; L[i] = hi; }
}
__device__ __forceinline__ void ce_desc(unsigned& a, unsigned& b) { const unsigned mx = a > b ? a : b, mn = a > b ? b : a; a = mx; b = mn; }
__device__ __forceinline__ void sort16_desc(unsigned (&x)[16]) {
    ce_desc(x[0], x[13]); ce_desc(x[1], x[12]); ce_desc(x[2], x[15]); ce_desc(x[3], x[14]); ce_desc(x[4], x[8]); ce_desc(x[5], x[6]); ce_desc(x[7], x[11]); ce_desc(x[9], x[10]);
    ce_desc(x[0], x[5]); ce_desc(x[1], x[7]); ce_desc(x[2], x[9]); ce_desc(x[3], x[4]); ce_desc(x[6], x[13]); ce_desc(x[8], x[14]); ce_desc(x[10], x[15]); ce_desc(x[11], x[12]);
    ce_desc(x[0], x[1]); ce_desc(x[2], x[3]); ce_desc(x[4], x[5]); ce_desc(x[6], x[8]); ce_desc(x[7], x[9]); ce_desc(x[10], x[11]); ce_desc(x[12], x[13]); ce_desc(x[14], x[15]);
    ce_desc(x[0], x[2]); ce_desc(x[1], x[3]); ce_desc(x[4], x[10]); ce_desc(x[5], x[11]); ce_desc(x[6], x[7]); ce_desc(x[8], x[9]); ce_desc(x[12], x[14]); ce_desc(x[13], x[15]);
    ce_desc(x[1], x[2]); ce_desc(x[3], x[12]); ce_desc(x[4], x[6]); ce_desc(x[5], x[7]); ce_desc(x[8], x[10]); ce_desc(x[9], x[11]); ce_desc(x[13], x[14]);
    ce_desc(x[1], x[4]); ce_desc(x[2], x[6]); ce_desc(x[5], x[8]); ce_desc(x[7], x[10]); ce_desc(x[9], x[13]); ce_desc(x[11], x[14]);
    ce_desc(x[2], x[4]); ce_desc(x[3], x[6]); ce_desc(x[9], x[12]); ce_desc(x[11], x[13]);
    ce_desc(x[3], x[5]); ce_desc(x[6], x[8]); ce_desc(x[7], x[9]); ce_desc(x[10], x[12]);
    ce_desc(x[3], x[4]); ce_desc(x[5], x[6]); ce_desc(x[7], x[8]); ce_desc(x[9], x[10]); ce_desc(x[11], x[12]);
    ce_desc(x[6], x[7]); ce_desc(x[8], x[9]);
}
__device__ __forceinline__ void merge16_desc(unsigned (&x)[16]) {
#pragma unroll
    for (int j = 8; j > 0; j >>= 1)
#pragma unroll
        for (int i = 0; i < 16; ++i) { const int l = i ^ j; if (l > i) ce_desc(x[i], x[l]); }
}
__device__ __forceinline__ void top16_merge(unsigned (&L)[16], const unsigned (&Tt)[16]) {
#pragma unroll
    for (int i = 0; i < 16; ++i) L[i] = L[i] > Tt[15 - i] ? L[i] : Tt[15 - i];
    merge16_desc(L);
}
struct QRaw { bf16x8 a[8], b[8]; };
__device__ __forceinline__ void route_load(Frame& F, int tg, int h, QRaw& q) {
    const int lane = F.lane, tok = tg * 32 + (lane & 31), hh = lane >> 5;
    const bf16* qrow = F.QB + (size_t)tok * NQ + h * 256 + 8 * hh;
#pragma unroll
    for (int ks = 0; ks < 8; ++ks) q.a[ks] = *(const GAS bf16x8*)(qrow + ks * 16);
#pragma unroll
    for (int ks = 0; ks < 8; ++ks) q.b[ks] = *(const GAS bf16x8*)(qrow + 128 + ks * 16);
}
__device__ __forceinline__ void route_job(Frame& F, int tg, int h, const QRaw& q) {
    const int lane = F.lane, tok = tg * 32 + (lane & 31), hh = lane >> 5;
    unsigned L1[16], L2[16];
#pragma unroll
    for (int i = 0; i < 16; ++i) { L1[i] = 0u; L2[i] = 0u; }
    bf16x8 bq[8], bqn[8];
#pragma unroll
    for (int ks = 0; ks < 8; ++ks) { bq[ks] = q.a[ks]; bqn[ks] = q.b[ks]; }
#pragma unroll 1
    for (int p = 0; p < 2; ++p) {
        const LAS unsigned short* krow = (const LAS unsigned short*)F.lds + (size_t)(p * 128 + (lane & 31)) * 136 + 8 * hh;
        unsigned L[16];
#pragma unroll
        for (int i = 0; i < 16; ++i) L[i] = 0u;
#pragma unroll 1
        for (int mt = 0; mt < 4; ++mt) { f32x16 acc;
#pragma unroll
            for (int r = 0; r < 16; ++r) acc[r] = 0.f;
#pragma unroll
            for (int ks = 0; ks < 8; ++ks) { const bf16x8 ak = *(const LAS bf16x8*)(krow + mt * 32 * 136 + ks * 16); acc = MFMA32(ak, bq[ks], acc); }
            unsigned Tt[16];
#pragma unroll
            for (int r = 0; r < 16; ++r) { const int n = 32 * mt + (r & 3) + 8 * (r >> 2) + 4 * hh; Tt[r] = (f2sort(acc[r]) & ~0x7Fu) | (unsigned)(127 - n); }
            sort16_desc(Tt); top16_merge(L, Tt); }
        unsigned Pp[16];
#pragma unroll
        for (int i = 0; i < 16; ++i) Pp[i] = (unsigned)__shfl_xor((int)L[i], 32);
        top16_merge(L, Pp);
#pragma unroll
        for (int i = 0; i < 16; ++i) { L1[i] = (p == 0) ? L[i] : L1[i]; L2[i] = (p == 0) ? L2[i] : L[i]; }
#pragma unroll
        for (int ks = 0; ks < 8; ++ks) bq[ks] = bqn[ks];
    }
    float v1[16], v2[16];
#pragma unroll
    for (int i = 0; i < 16; ++i) { v1[i] = sort2f(L1[i] & ~0x7Fu); v2[i] = sort2f(L2[i] & ~0x7Fu); }
    LAS unsigned char* tbl = (LAS unsigned char*)(F.lds + 69632 + F.wave * 2048) + lane;
#pragma unroll
    for (int i = 0; i < 16; ++i) { tbl[i * 64] = (unsigned char)(127u - (L1[i] & 0x7Fu)); tbl[(16 + i) * 64] = (unsigned char)(127u - (L2[i] & 0x7Fu)); }
#define CKEY(i, j) ((f2sort(v1[i] + v2[j]) & ~0xFFu) | (unsigned)(255 - ((i) * 16 + (j))))
    unsigned C[16], G[16];
#pragma unroll
    for (int j = 0; j < 16; ++j) C[j] = CKEY(0, j);
#pragma unroll
    for (int j = 0; j < 8; ++j) G[j] = CKEY(1, j);
#pragma unroll
    for (int j = 0; j < 5; ++j) G[8 + j] = CKEY(2, j);
#pragma unroll
    for (int j = 0; j < 3; ++j) G[13 + j] = CKEY(4, j);
    sort16_desc(G); top16_merge(C, G);
#pragma unroll
    for (int j = 0; j < 4; ++j) G[j] = CKEY(3, j);
    G[4] = CKEY(5, 0); G[5] = CKEY(5, 1); G[6] = CKEY(6, 0); G[7] = CKEY(6, 1); G[8] = CKEY(7, 0); G[9] = CKEY(7, 1);
#pragma unroll
    for (int i = 0; i < 6; ++i) G[10 + i] = CKEY(8 + i, 0);
    sort16_desc(G); top16_merge(C, G);
    insert16(C, CKEY(14, 0)); insert16(C, CKEY(15, 0));
#undef CKEY
    const float m = sort2f(C[0] & ~0xFFu); float e[16]; int id[16]; float sum = 0.f;
#pragma unroll
    for (int r = 0; r < 16; ++r) { e[r] = __expf(sort2f(C[r] & ~0xFFu) - m); sum += e[r]; const int code = 255 - (int)(C[r] & 0xFFu); id[r] = (int)tbl[(code >> 4) * 64] * 128 + (int)tbl[(16 + (code & 15)) * 64]; }
    const float inv = rcp_f(sum);
    if (hh == 0) { int* ip = F.IDX + (size_t)tok * 128 + h * 16;
#pragma unroll
        for (int k = 0; k < 4; ++k) { i32x4 w4;
#pragma unroll
            for (int j = 0; j < 4; ++j) w4[j] = (int)((pk2(0.f, e[4 * k + j] * inv) & 0xffff0000u) | (unsigned)id[4 * k + j]);
            *(GAS i32x4*)(ip + 4 * k) = w4; } }
}

__device__ __forceinline__ float ub0(unsigned w) { return (float)(w & 0xffu); }
__device__ __forceinline__ float ub1(unsigned w) { return (float)((w >> 8) & 0xffu); }
__device__ __forceinline__ float ub2(unsigned w) { return (float)((w >> 16) & 0xffu); }
__device__ __forceinline__ float ub3(unsigned w) { return (float)(w >> 24); }
constexpr int NSMAX = 132;
constexpr unsigned P10_DUMMY = 0xffffffffu;
#ifndef P10_FAKE_W
#define P10_FAKE_W 16384
#endif
__device__ __forceinline__ int pk_i8(float a, float b, float c, float d, float inv) {
    return (int)(((unsigned)(int)rintf(a * inv) & 0xffu) | (((unsigned)(int)rintf(b * inv) & 0xffu) << 8) | (((unsigned)(int)rintf(c * inv) & 0xffu) << 16) | (((unsigned)(int)rintf(d * inv) & 0xffu) << 24)); }
template <bool FAKE> __device__ __forceinline__ void peer_round(Frame& F, int quad) {
    constexpr bool U4 = P10_U4 != 0, V4 = P10_V4 != 0;
    const int lane = F.lane, grp = lane >> 4, i = lane & 15;
    const int tb = quad * 4;
    LAS v2u* lst = (LAS v2u*)(F.lds + F.wave * 4352);
#pragma unroll
    for (int tk = 0; tk < 4; ++tk) { const int t = tb + tk;
        const unsigned wa = (unsigned)F.IDX[(size_t)t * 128 + lane], wb = (unsigned)F.IDX[(size_t)t * 128 + 64 + lane];
        lst[tk * NSMAX + lane] = (v2u){wa & 0xffffu, wa & 0xffff0000u};
        lst[tk * NSMAX + 64 + lane] = (v2u){wb & 0xffffu, wb & 0xffff0000u};
        if (lane < NSMAX - 128) lst[tk * NSMAX + 128 + lane] = (v2u){(unsigned)F.IDX[(size_t)t * 128 + 127] & 0xffffu, 0u}; }
    const int NS = 129;
    const int t = tb + grp; int hq[16]; float sh;
#if G3_I8
    {
      static_assert(P10_U4 != 0, "the int8-activation path below is written for the 4-bit expert records");
      const unsigned char* hp = (const unsigned char*)F.XN + (size_t)t * DM + i * 32; sh = F.SA[t];
      const v4u h0 = *(const GAS v4u*)hp, h1 = *(const GAS v4u*)(hp + 16), h2 = *(const GAS v4u*)(hp + 512), h3 = *(const GAS v4u*)(hp + 528);
      const unsigned hw[16] = {h0.x, h0.y, h0.z, h0.w, h1.x, h1.y, h1.z, h1.w, h2.x, h2.y, h2.z, h2.w, h3.x, h3.y, h3.z, h3.w};
#pragma unroll
      for (int k = 0; k < 8; ++k) { unsigned hi_ = 0u, lo_ = 0u;
#pragma unroll
          for (int e = 0; e < 8; ++e) { const int qv = (int)(signed char)(hw[2 * k + (e >> 2)] >> (8 * (e & 3))); const int lo = ((qv + 8) & 15) - 8, hi = (qv - lo) >> 4; lo_ |= ((unsigned)lo & 15u) << (4 * e); hi_ |= ((unsigned)hi & 15u) << (4 * e); }
          hq[2 * k] = (int)hi_; hq[2 * k + 1] = (int)lo_; } }
#else
    { float hv[64]; float mx = 0.f;
      const int bq = t >> 13; const float* gmv = F.GM + (size_t)bq * 1024; const float* shv = F.MOD + (size_t)bq * 6144 + 3072;
      float ssv = F.SSQ[(size_t)t * 16 + i]; ssv += __shfl_xor(ssv, 1); ssv += __shfl_xor(ssv, 2); ssv += __shfl_xor(ssv, 4); ssv += __shfl_xor(ssv, 8);
      const float rstd = rsq_f(ssv * (1.f / DM) + EPS);
#pragma unroll
      for (int c8 = 0; c8 < 8; ++c8) { const int col = U4 ? ((c8 >> 2) * 512 + i * 32 + (c8 & 3) * 8) : ((c8 >> 1) * 256 + i * 16 + (c8 & 1) * 8); const bf16* hp = F.X1 + (size_t)t * DM + col;
          const v4u w = *(const GAS v4u*)hp; const unsigned ww[4] = {w.x, w.y, w.z, w.w};
          const f32x4 g0 = *(const GAS f32x4*)(gmv + col), g1 = *(const GAS f32x4*)(gmv + col + 4), s0 = *(const GAS f32x4*)(shv + col), s1 = *(const GAS f32x4*)(shv + col + 4);
          const float gg[8] = {g0.x, g0.y, g0.z, g0.w, g1.x, g1.y, g1.z, g1.w}, sv[8] = {s0.x, s0.y, s0.z, s0.w, s1.x, s1.y, s1.z, s1.w};
#pragma unroll
          for (int j = 0; j < 4; ++j) { const float lo = bflo(ww[j]) * rstd * gg[2 * j] + sv[2 * j], hi = bfhi(ww[j]) * rstd * gg[2 * j + 1] + sv[2 * j + 1]; hv[c8 * 8 + 2 * j] = lo; hv[c8 * 8 + 2 * j + 1] = hi; mx = fmaxf(mx, fmaxf(fabsf(lo), fabsf(hi))); } }
      mx = fmaxf(mx, __shfl_xor(mx, 1)); mx = fmaxf(mx, __shfl_xor(mx, 2)); mx = fmaxf(mx, __shfl_xor(mx, 4)); mx = fmaxf(mx, __shfl_xor(mx, 8));
      const float qmax = U4 ? 119.f : 127.f; const float inv = mx > 0.f ? qmax / mx : 0.f; sh = mx / qmax;
#pragma unroll
      for (int k = 0; k < 8; ++k) {
          if (U4) { unsigned hi_ = 0u, lo_ = 0u;
#pragma unroll
              for (int e = 0; e < 8; ++e) { const int qv = (int)rintf(hv[8 * k + e] * inv); const int lo = ((qv + 8) & 15) - 8, hi = (qv - lo) >> 4; lo_ |= ((unsigned)lo & 15u) << (4 * e); hi_ |= ((unsigned)hi & 15u) << (4 * e); }
              hq[2 * k] = (int)hi_; hq[2 * k + 1] = (int)lo_; }
          else { hq[2 * k] = pk_i8(hv[8 * k], hv[8 * k + 1], hv[8 * k + 2], hv[8 * k + 3], inv); hq[2 * k + 1] = pk_i8(hv[8 * k + 4], hv[8 * k + 5], hv[8 * k + 6], hv[8 * k + 7], inv); } } }
#endif
    float y[64]; float asum = 0.f, asum1 = 0.f;
#pragma unroll
    for (int k = 0; k < 64; ++k) y[k] = 0.f;
    LDS_WAIT();
    const LAS v2u* mylst = lst + grp * NSMAX;
#define P10_LOAD(r_, U, V, SU, SV, GT) do { const v2u kg_ = mylst[(r_)]; const int id0_ = (int)kg_.x; const int id_ = FAKE ? (int)((((unsigned)id0_ * 2654435761u) >> 7) & (P10_FAKE_W - 1)) : id0_; GT = __uint_as_float(kg_.y); \
        const unsigned char* ur_ = F.UT + (size_t)id_ * P10_REC; const unsigned char* vr_ = ur_ + P10_UB; \
        if (U4) { U[0] = *(const GAS v4u*)(ur_ + i * 16); U[1] = *(const GAS v4u*)(ur_ + 256 + i * 16); V[0] = *(const GAS v4u*)(vr_ + i * 16); V[1] = *(const GAS v4u*)(vr_ + 256 + i * 16); \
            const v2u sc_ = *(const GAS v2u*)(ur_ + 1024 + i * 8); SU = __uint_as_float(sc_.x); SV = __uint_as_float(sc_.y); }     \
        else { _Pragma("unroll") for (int sg = 0; sg < 4; ++sg) U[sg] = *(const GAS v4u*)(ur_ + sg * 256 + i * 16); SU = F.USC[id_]; \
            _Pragma("unroll") for (int sg = 0; sg < 4; ++sg) V[sg] = *(const GAS v4u*)(vr_ + sg * 256 + i * 16); SV = F.VSC[id_]; } } while (0)
#define P10_COMP(U, V, SU, SV, GT) do { float dact_; \
        if (U4) { const unsigned uw_[8] = {U[0].x, U[0].y, U[0].z, U[0].w, U[1].x, U[1].y, U[1].z, U[1].w}; int d0_ = 0, d1_ = 0; \
            int e0_ = 0, e1_ = 0; \
            _Pragma("unroll") for (int k = 0; k < 4; ++k) { d0_ = __builtin_amdgcn_sdot8((int)uw_[k], hq[2 * k], d0_, false); e0_ = __builtin_amdgcn_sdot8((int)uw_[k], hq[2 * k + 1], e0_, false); } \
            _Pragma("unroll") for (int k = 4; k < 8; ++k) { d1_ = __builtin_amdgcn_sdot8((int)uw_[k], hq[2 * k], d1_, false); e1_ = __builtin_amdgcn_sdot8((int)uw_[k], hq[2 * k + 1], e1_, false); } \
            const unsigned sb_ = __float_as_uint(SU); float df_ = bflo(sb_) * (float)(16 * d0_ + e0_) + bfhi(sb_) * (float)(16 * d1_ + e1_); \
            df_ += __shfl_xor(df_, 1); df_ += __shfl_xor(df_, 2); df_ += __shfl_xor(df_, 4); df_ += __shfl_xor(df_, 8); dact_ = df_ * sh; } \
        else { int d_ = 0; \
            _Pragma("unroll") for (int sg = 0; sg < 4; ++sg) { d_ = __builtin_amdgcn_sdot4((int)U[sg].x, hq[sg * 4], d_, false); d_ = __builtin_amdgcn_sdot4((int)U[sg].y, hq[sg * 4 + 1], d_, false); d_ = __builtin_amdgcn_sdot4((int)U[sg].z, hq[sg * 4 + 2], d_, false); d_ = __builtin_amdgcn_sdot4((int)U[sg].w, hq[sg * 4 + 3], d_, false); } \
            d_ += __shfl_xor(d_, 1); d_ += __shfl_xor(d_, 2); d_ += __shfl_xor(d_, 4); d_ += __shfl_xor(d_, 8); dact_ = (float)d_ * (SU * sh); } \
        const float ag_ = gelu_fast(dact_) * GT; \
        if (V4 && P10_VFP4) { const unsigned vb_ = __float_as_uint(SV); const float a0_ = ag_ * bflo(vb_), a1_ = ag_ * bfhi(vb_); \
            const unsigned vw_[8] = {V[0].x, V[0].y, V[0].z, V[0].w, V[1].x, V[1].y, V[1].z, V[1].w}; \
            _Pragma("unroll") for (int k = 0; k < 8; ++k) { const float a_ = k < 4 ? a0_ : a1_; \
                const f32x2 f0_ = __builtin_amdgcn_cvt_scalef32_pk_f32_fp4(vw_[k], 1.f, 0), f1_ = __builtin_amdgcn_cvt_scalef32_pk_f32_fp4(vw_[k], 1.f, 1), f2_ = __builtin_amdgcn_cvt_scalef32_pk_f32_fp4(vw_[k], 1.f, 2), f3_ = __builtin_amdgcn_cvt_scalef32_pk_f32_fp4(vw_[k], 1.f, 3); \
                y[8 * k] += a_ * f0_.x; y[8 * k + 1] += a_ * f0_.y; y[8 * k + 2] += a_ * f1_.x; y[8 * k + 3] += a_ * f1_.y; y[8 * k + 4] += a_ * f2_.x; y[8 * k + 5] += a_ * f2_.y; y[8 * k + 6] += a_ * f3_.x; y[8 * k + 7] += a_ * f3_.y; } } \
        else if (V4) { const unsigned vb_ = __float_as_uint(SV); const float a0_ = ag_ * bflo(vb_), a1_ = ag_ * bfhi(vb_); asum += a0_; asum1 += a1_; \
            const unsigned vw_[8] = {V[0].x, V[0].y, V[0].z, V[0].w, V[1].x, V[1].y, V[1].z, V[1].w}; \
            _Pragma("unroll") for (int k = 0; k < 8; ++k) { const unsigned lo_ = vw_[k]; unsigned hi_ = vw_[k] & 0xf0f0f0f0u; asm volatile("" : "+v"(hi_));        \
                const float a_ = k < 4 ? a0_ : a1_;   \
                y[8 * k] += a_ * ub0(lo_); y[8 * k + 1] += a_ * ub1(lo_); y[8 * k + 2] += a_ * ub2(lo_); y[8 * k + 3] += a_ * ub3(lo_); y[8 * k + 4] += a_ * ub0(hi_); y[8 * k + 5] += a_ * ub1(hi_); y[8 * k + 6] += a_ * ub2(hi_); y[8 * k + 7] += a_ * ub3(hi_); } } \
        else { const float a_ = ag_ * SV; asum += a_; \
            _Pragma("unroll") for (int sg = 0; sg < 4; ++sg) { const unsigned xw_[4] = {V[sg].x, V[sg].y, V[sg].z, V[sg].w}; \
                _Pragma("unroll") for (int j = 0; j < 4; ++j) { y[sg * 16 + 4 * j] += a_ * ub0(xw_[j]); y[sg * 16 + 4 * j + 1] += a_ * ub1(xw_[j]); y[sg * 16 + 4 * j + 2] += a_ * ub2(xw_[j]); y[sg * 16 + 4 * j + 3] += a_ * ub3(xw_[j]); } } } } while (0)
#ifndef P10_DEPTH
#define P10_DEPTH 2
#endif
#ifndef P10_LOOP_SHIFT
#define P10_LOOP_SHIFT 1
#endif
#define P10_STR2(x) #x
#define P10_STR(x) P10_STR2(x)
#ifndef P10_FENCED
#define P10_FENCED 0
#endif
#define P10_FENCE do { if (P10_FENCED) __builtin_amdgcn_sched_barrier(0); } while (0)
    if (P10_DEPTH == 3) {
        v4u uA[4], vA[4], uB[4], vB[4], uC[4], vC[4]; float suA, svA, suB, svB, suC, svC, gtA, gtB, gtC;
        const int last = NS - 1;
        P10_LOAD(0, uA, vA, suA, svA, gtA); P10_LOAD(1, uB, vB, suB, svB, gtB);
#pragma unroll 1
        for (int r = 0; r < NS; r += 3) {
            { const int rn = r + 2; P10_LOAD(rn, uC, vC, suC, svC, gtC); } P10_FENCE;
            P10_COMP(uA, vA, suA, svA, gtA); P10_FENCE;
            { const int rn = r + 3 < NS ? r + 3 : last; P10_LOAD(rn, uA, vA, suA, svA, gtA); } P10_FENCE;
            P10_COMP(uB, vB, suB, svB, gtB); P10_FENCE;
            { const int rn = r + 4 < NS ? r + 4 : last; P10_LOAD(rn, uB, vB, suB, svB, gtB); } P10_FENCE;
            P10_COMP(uC, vC, suC, svC, gtC); P10_FENCE;
        }
    } else if (P10_DEPTH == 4) {
        v4u uA[4], vA[4], uB[4], vB[4], uC[4], vC[4], uD[4], vD[4]; float suA, svA, suB, svB, suC, svC, suD, svD, gtA, gtB, gtC, gtD;
        P10_LOAD(0, uA, vA, suA, svA, gtA); P10_LOAD(1, uB, vB, suB, svB, gtB); P10_LOAD(2, uC, vC, suC, svC, gtC);
#pragma unroll 1
        for (int r = 0; r < 128; r += 4) {
            { const int rn = r + 3; P10_LOAD(rn, uD, vD, suD, svD, gtD); } P10_FENCE;
            P10_COMP(uA, vA, suA, svA, gtA); P10_FENCE;
            { const int rn = r + 4 < 128 ? r + 4 : 127; P10_LOAD(rn, uA, vA, suA, svA, gtA); } P10_FENCE;
            P10_COMP(uB, vB, suB, svB, gtB); P10_FENCE;
            { const int rn = r + 5 < 128 ? r + 5 : 127; P10_LOAD(rn, uB, vB, suB, svB, gtB); } P10_FENCE;
            P10_COMP(uC, vC, suC, svC, gtC); P10_FENCE;
            { const int rn = r + 6 < 128 ? r + 6 : 127; P10_LOAD(rn, uC, vC, suC, svC, gtC); } P10_FENCE;
            P10_COMP(uD, vD, suD, svD, gtD); P10_FENCE;
        }
    } else {
        v4u uA[4], vA[4], uB[4], vB[4]; float suA, svA, suB, svB, gtA, gtB;
        P10_LOAD(0, uA, vA, suA, svA, gtA);
        asm volatile(".p2align 8\n\t.rept " P10_STR(P10_LOOP_SHIFT) "\n\ts_nop 0\n\t.endr" ::);
#pragma unroll 1
        for (int r = 0; r < 128; r += 2) {
            { const int rn = r + 1; P10_LOAD(rn, uB, vB, suB, svB, gtB); } P10_FENCE;
            P10_COMP(uA, vA, suA, svA, gtA); P10_FENCE;
            { const int rn = r + 2 < 128 ? r + 2 : 127; P10_LOAD(rn, uA, vA, suA, svA, gtA); } P10_FENCE;
            P10_COMP(uB, vB, suB, svB, gtB); P10_FENCE;
        }
    }
#define P10_YI(m, j) ((V4 && !P10_VFP4) ? (8 * ((m) >> 1) + 2 * ((m) & 1) + ((j) >> 1) + 4 * ((j) & 1)) : (4 * (m) + (j)))
    { const int b = t >> 13; const float* g2 = F.MOD + (size_t)b * 6144 + 5120; const bf16* xr2 = F.X1 + (size_t)t * DM; float ss = 0.f;
#pragma unroll
      for (int m = 0; m < 16; ++m) { const int col = V4 ? ((m >> 3) * 512 + i * 32 + 4 * (m & 7)) : ((m >> 2) * 256 + i * 16 + 4 * (m & 3)); const float yoff = (V4 && P10_VFP4) ? 0.f : V4 ? 8.f * (m < 8 ? asum : asum1) : 128.f * asum;
          const v2u xw = *(const GAS v2u*)(xr2 + col); const f32x4 ga = *(const GAS f32x4*)(g2 + col); const float xs[4] = {bflo(xw.x), bfhi(xw.x), bflo(xw.y), bfhi(xw.y)}, gs[4] = {ga.x, ga.y, ga.z, ga.w};
          float yv[4];
#pragma unroll
          for (int j = 0; j < 4; ++j) yv[j] = (!V4 || P10_VFP4) ? y[P10_YI(m, j)] : ((j & 1) ? y[P10_YI(m, j)] * 0.0625f : y[P10_YI(m, j)] - y[P10_YI(m, j + 1)]);
#pragma unroll
          for (int j = 0; j < 4; ++j) { const float zz = xs[j] + gs[j] * (yv[j] - yoff); y[P10_YI(m, j)] = zz; ss += zz * zz; } }
      ss += __shfl_xor(ss, 1); ss += __shfl_xor(ss, 2); ss += __shfl_xor(ss, 4); ss += __shfl_xor(ss, 8);
      const float rs = rsq_f(ss * (1.f / DM) + EPS); const float* fg = F.final_g; float* orow = F.out + (size_t)t * DM;
      if (FAKE) { if (i == 0) F.DEC[t] = rs + y[3]; }
      else {
#pragma unroll
      for (int m = 0; m < 16; ++m) { const int col = V4 ? ((m >> 3) * 512 + i * 32 + 4 * (m & 7)) : ((m >> 2) * 256 + i * 16 + 4 * (m & 3)); const f32x4 fa = *(const GAS f32x4*)(fg + col);
          *(GAS f32x4*)(orow + col) = (f32x4){y[P10_YI(m, 0)] * rs * fa.x, y[P10_YI(m, 1)] * rs * fa.y, y[P10_YI(m, 2)] * rs * fa.z, y[P10_YI(m, 3)] * rs * fa.w}; } } }
    LDS_WAIT();
}

struct Args { const float* in[20]; float* out; unsigned char* ws; int ph_lo, ph_hi, li, pad; };
__global__ void __launch_bounds__(NWAVES * 64, 2) hymba_fwd(Args args) {
    extern __shared__ __attribute__((aligned(16))) unsigned char lds[];
    Frame F;
    F.lds = (LAS unsigned char*)lds;
    F.MISC = (volatile LAS unsigned*)(F.lds + MISC_OFF);
    F.tid = threadIdx.x; F.lane = F.tid & 63; F.wave = __builtin_amdgcn_readfirstlane(F.tid >> 6);
    F.G = gridDim.x; { const int bx = blockIdx.x; F.vcu = (F.G % 8 == 0) ? (bx % 8) * (F.G / 8) + bx / 8 : bx; }
    unsigned char* ws = args.ws;
    F.ctl = (gu32*)(ws + WS_CTL);
    F.x = args.in[0]; F.c = args.in[1]; F.ada_w = args.in[2]; F.ada_b = args.in[3]; F.norm1_g = args.in[4]; F.w_in = args.in[5]; F.lb_gamma = args.in[6]; F.hgrn_g = args.in[7];
    F.ln_g = args.in[8]; F.ln_b = args.in[9]; F.sp_w = args.in[10]; F.sp_b = args.in[11]; F.gm_g = args.in[12]; F.w_out = args.in[13]; F.norm2_g = args.in[14]; F.wq = args.in[15];
    F.keys = args.in[16]; F.pu = args.in[17]; F.pv = args.in[18]; F.final_g = args.in[19]; F.out = args.out;
    F.MODP = (float*)(ws + WS_MODP); F.MOD = (float*)(ws + WS_MOD); F.LB = (float*)(ws + WS_LB); F.SW = (float*)(ws + WS_SW); F.SA = (float*)(ws + WS_SA); F.DEC = (float*)(ws + WS_DEC); F.X1 = (bf16*)(ws + WS_X1); F.GATE = (float*)(ws + WS_GATE); F.IDX = (int*)(ws + WS_IDX);
    F.WIN = (bf16*)(ws + WS_WIN); F.WOUT = (bf16*)(ws + WS_WOUT); F.WQ = (bf16*)(ws + WS_WQ); F.KEYS = (bf16*)(ws + WS_KEYS); F.SPW = (bf16*)(ws + WS_SPW);
    F.UT = ws + WS_UT; F.VT = ws + WS_VT; F.USC = (float*)(ws + WS_USC); F.VSC = (float*)(ws + WS_VSC); F.XN = (bf16*)(ws + WS_XN); F.PROJ = (bf16*)(ws + WS_PROJ); F.QB = (bf16*)(ws + WS_PROJ);
    F.STATE = (bf16*)(ws + WS_STATE); F.CAT = (bf16*)(ws + WS_CAT);
    F.QBIAS = (float*)(ws + WS_QBIAS); F.GM = (float*)(ws + WS_GM); F.SSQ = (float*)(ws + WS_SSQ); F.WQF = (bf16*)(ws + WS_WQF);
    for (int u = F.tid; u < (LDS_BYTES - LDSCTL_OFF) / 4; u += NWAVES * 64) ((LAS unsigned*)(F.lds + LDSCTL_OFF))[u] = 0u;
    __syncthreads();
    XcdBarrier bar; bar.bar = (unsigned*)(F.ctl + CW_BAR); bar.x = 0; bar.st = nullptr;
    if (!MK_PER_PHASE) bar = xcd_barrier_post((unsigned*)(F.ctl + CW_BAR), F.MISC + 8);
    const int lo = args.ph_lo, hi = args.ph_hi;
#ifndef PHMASK
#define PHMASK 0x7ff
#endif
#define IN(k) (((PHMASK >> (k)) & 1) && lo <= (k) && (k) < hi)
#define SEAM(k) do { if (IN(k) && IN((k) + 1)) xcd_barrier(bar); } while (0)

#ifndef PHREP
#define PHREP 0
#endif
#ifndef P10_HALF
#define P10_HALF 0
#endif
#define REP2(k) ((PHREP >> (k)) & 1)
#define PH0 do { p0_prologue(F); __syncthreads(); } while (0)
#define PH1 do { p1_norm1(F); __syncthreads(); } while (0)
#if G1_I8
#define PH2 do { pg8::Gemm g{F.XN, F.WIN, T, NPROJ, DM / 2};     \
        pg8::StaticOrder S; S.init(T, NPROJ, F.G, (int)blockIdx.x); pg8::EpiBf16S E{F.PROJ, NPROJ, F.SA, F.SW}; \
        pg8::gemm_phase<pg8::EpiBf16S, pg8::StaticOrder, true, true, true>(F.lds, g, S, E); } while (0)
#else
#define PH2 do { pg8::Gemm g{F.XN, F.WIN, T, NPROJ, DM}; pg8::StaticOrder S; S.init(T, NPROJ, F.G, (int)blockIdx.x); pg8::EpiBf16 E{F.PROJ, NPROJ}; \
        pg8::gemm_phase<pg8::EpiBf16, pg8::StaticOrder, true, true>(F.lds, g, S, E); } while (0)
#endif
#define PH3A do { HRawA ra_, rb_; hgrnA_load(F, F.vcu, ra_);        \
        for (int u = F.vcu; u < 2048; u += 2 * F.G) { hgrnA_load(F, u + F.G, rb_); hgrnA_unit(F, u, ra_); hgrnA_load(F, u + 2 * F.G < 2048 ? u + 2 * F.G : u, ra_); hgrnA_unit(F, u + F.G, rb_); } } while (0)
#define PH3 do { PH3A; for (int u = F.vcu; u < 256; u += F.G) gmlp_unit(F, u); } while (0)
#define PH5 do { HRawC ra_, rb_; hgrnC_load(F, F.vcu, ra_);        \
        for (int u = F.vcu; u < 2048; u += 2 * F.G) { hgrnC_load(F, u + F.G, rb_); hgrnC_unit(F, u, ra_); hgrnC_load(F, u + 2 * F.G < 2048 ? u + 2 * F.G : u, ra_); hgrnC_unit(F, u + F.G, rb_); } } while (0)
#define PH6 do { pg8::Gemm g{F.CAT, F.WOUT, T, DM, DM}; pg8::StaticOrder S; S.init(T, DM, F.G, (int)blockIdx.x); pg8::EpiResid E{F.x, F.X1, F.MOD + 2048, 6144, SEQ, DM, F.SSQ}; \
        pg8::gemm_phase<pg8::EpiResid, pg8::StaticOrder, true, true>(F.lds, g, S, E); } while (0)
#define PH7 do { } while (0)
#if G3_I8
#define PH8 do { pg8::Gemm g{F.XN, F.WQ, T, NQ, DM / 2}; pg8::StaticOrder S; S.init(T, NQ, F.G, (int)blockIdx.x); pg8::EpiBf16S E{F.QB, NQ, F.SA, F.SW + NPROJ}; \
        pg8::gemm_phase<pg8::EpiBf16S, pg8::StaticOrder, true, true, true>(F.lds, g, S, E); } while (0)
#else
#define PH8 do { pg8::Gemm g{F.X1, F.WQF, T, NQ, DM, 5};        \
        pg8::StaticOrder S; S.init(T, NQ, F.G, (int)blockIdx.x); pg8::EpiQ E{F.QB, NQ, F.SSQ, F.QBIAS, 5}; \
        pg8::gemm_phase<pg8::EpiQ, pg8::StaticOrder, true, true>(F.lds, g, S, E); } while (0)
#endif
#define PH9 do {   \
        pg8::StaticOrder S9_; S9_.init(T, NQ, F.G, (int)blockIdx.x); pg8::Unit u9_; \
        for (int i9_ = 0; S9_.next(i9_, u9_); ++i9_) { const int h_ = u9_.pn; QRaw q9_; route_load(F, u9_.pm * 8 + F.wave, h_, q9_);        \
            { v4u kv_[8]; \
              _Pragma("unroll") for (int j_ = 0; j_ < 8; ++j_) { const int c_ = F.tid + 512 * j_; kv_[j_] = *(const GAS v4u*)(F.KEYS + (size_t)(h_ * 256 + (c_ >> 4)) * 128 + (c_ & 15) * 8); } \
              _Pragma("unroll") for (int j_ = 0; j_ < 8; ++j_) { const int c_ = F.tid + 512 * j_; *(LAS v4u*)((LAS unsigned short*)F.lds + (c_ >> 4) * 136 + (c_ & 15) * 8) = kv_[j_]; } } \
            __syncthreads(); \
            route_job(F, u9_.pm * 8 + F.wave, h_, q9_); __syncthreads(); } } while (0)
    if (IN(0)) { PH0; if (REP2(0)) PH0; } SEAM(0);
    if (IN(1)) { PH1; if (REP2(1)) PH1; } SEAM(1);
    if (IN(2)) { PH2; if (REP2(2)) PH2; } SEAM(2);
    if (IN(3)) { PH3; if (REP2(3)) { PH3A; } if (REP2(11)) { for (int u = F.vcu; u < 256; u += F.G) gmlp_unit(F, u); } } SEAM(3);
#ifndef XBARS
#define XBARS 0
#endif
    if (IN(4)) { p4_qbias(F); p4_scan(F); if (REP2(4)) p4_scan(F); for (int xb = 0; xb < XBARS; ++xb) xcd_barrier(bar); } SEAM(4);
    if (IN(5)) { PH5; if (REP2(5)) PH5; } SEAM(5);
    if (IN(6)) { PH6; if (REP2(6)) PH6; } SEAM(6);
    if (IN(8)) { PH8; if (REP2(8)) PH8; VM_WAIT(); __syncthreads(); }
    if (IN(9)) { PH9; if (REP2(9)) PH9; } SEAM(9);
    if (IN(10)) {
        const int gw = F.vcu * NWAVES + F.wave;
        if (REP2(10)) { for (int rd = 0; rd < 4; ++rd) peer_round<false>(F, rd * 2048 + gw); }
#if P10_HALF
        if (F.vcu & 1) return;
        peer_round<false>(F, gw + NWAVES);
#endif
        int q = gw;
        while (q < T / 4) { peer_round<false>(F, q);
            int nq = 0; if (F.lane == 0) nq = (int)__hip_atomic_fetch_add(F.ctl + 16, 1u, __ATOMIC_RELAXED, __HIP_MEMORY_SCOPE_AGENT);
            q = F.G * NWAVES + __builtin_amdgcn_readfirstlane(nq); }
    }
#undef IN
#undef SEAM
}

extern "C" void kernel_launch(void* const* d_in, const int* in_sizes, int n_in, void* d_out, int out_size, void* d_ws, size_t ws_size, hipStream_t stream) {
    static int grid = 0;
    if (grid == 0) {
        if (n_in != 20 || in_sizes[0] != T * DM || out_size != T * DM || ws_size < WS_END) { fprintf(stderr, "kernel_launch: unexpected shapes (n_in %d, in0 %d, out %d, ws %zu); nothing launched\n", n_in, n_in > 0 ? in_sizes[0] : -1, out_size, ws_size); grid = -1; return; }
        if (hipFuncSetAttribute((const void*)hymba_fwd, hipFuncAttributeMaxDynamicSharedMemorySize, LDS_BYTES) != hipSuccess) { fprintf(stderr, "kernel_launch: hipFuncSetAttribute failed\n"); grid = -1; return; }
        int per_cu = 0;
        if (hipOccupancyMaxActiveBlocksPerMultiprocessor(&per_cu, (const void*)hymba_fwd, NWAVES * 64, LDS_BYTES) != hipSuccess || per_cu < 1)
            fprintf(stderr, "kernel_launch: note: occupancy query reports %d workgroups per CU\n", per_cu);
        (void)hipGetLastError();
        grid = 256;
    }
    if (grid < 0) return;
    if (hipMemsetAsync((char*)d_ws + WS_CTL, 0, CTL_ZERO_BYTES, stream) != hipSuccess) { fprintf(stderr, "kernel_launch: hipMemsetAsync failed\n"); return; }
    Args a{};
    for (int i = 0; i < 20; ++i) a.in[i] = (const float*)d_in[i];
    a.out = (float*)d_out; a.ws = (unsigned char*)d_ws;
#if MK_PER_PHASE
    for (int li = 0; li < NPHASE; ++li) { a.ph_lo = li; a.ph_hi = li + 1; a.li = li; hipLaunchKernelGGL(hymba_fwd, dim3(grid), dim3(NWAVES * 64), LDS_BYTES, stream, a); }
#else
    a.ph_lo = 0; a.ph_hi = NPHASE; a.li = 0; hipLaunchKernelGGL(hymba_fwd, dim3(grid), dim3(NWAVES * 64), LDS_BYTES, stream, a);
#endif
    const hipError_t le = hipPeekAtLastError();
    if (le != hipSuccess) fprintf(stderr, "kernel_launch: launch failed: %s\n", hipGetErrorName(le));
}
```
